# Optimizing an MI355X kernel written in HIP

```python
import math
import jax, jax.numpy as jnp
from jax import lax
import numpy as np

D_MODEL = 1024
BATCH = 4
SEQ = 8192
DEPTH = 1

CHUNK = 64
Q_BLOCK = 128
ATT_WIDTH = D_MODEL // 2
N_DIFF_HEADS = 4
DIFF_HEAD_DIM = ATT_WIDTH // (2 * N_DIFF_HEADS)
GMLP_WIDTH = D_MODEL - ATT_WIDTH
N_GMLP_GROUPS = 4
GMLP_GROUP_DIM = GMLP_WIDTH // N_GMLP_GROUPS
GMLP_CHUNK = 128
IN_WIDTH = 3 * ATT_WIDTH + 2 * GMLP_WIDTH
D_FF = 2816
CONV_WIDTH = 3
ROPE_THETA = 10000.0
LN_EPS = 1e-5
DEEPNORM_ALPHA = (2 * DEPTH) ** 0.25
DEEPNORM_BETA = (8 * DEPTH) ** -0.25

kernel_name = "hybrid_diffattn_gmlp_convffn_deepnorm"


def layer_norm(x, g, b):
    xf = x.astype(jnp.float32)
    mu = jnp.mean(xf, axis=-1, keepdims=True)
    var = jnp.mean(jnp.square(xf - mu), axis=-1, keepdims=True)
    y = (xf - mu) * lax.rsqrt(var + LN_EPS) * g.astype(jnp.float32) + b.astype(jnp.float32)
    return y.astype(x.dtype)


def rms_norm(x, g):
    xf = x.astype(jnp.float32)
    y = xf * lax.rsqrt(jnp.mean(jnp.square(xf), axis=-1, keepdims=True) + LN_EPS) * g.astype(jnp.float32)
    return y.astype(x.dtype)


def rope_tables(seq_len):
    pos = jnp.arange(seq_len, dtype=jnp.float32)
    inv_freq = 1.0 / (ROPE_THETA ** (jnp.arange(0, DIFF_HEAD_DIM, 2, dtype=jnp.float32) / DIFF_HEAD_DIM))
    ang = pos[:, None] * inv_freq[None, :]
    ang = jnp.concatenate([ang, ang], axis=-1)
    return jnp.cos(ang), jnp.sin(ang)


def apply_rope(t, cos, sin):
    half = DIFF_HEAD_DIM // 2
    t1, t2 = t[..., :half], t[..., half:]
    rot = jnp.concatenate([-t2, t1], axis=-1)
    out = t.astype(jnp.float32) * cos[None, :, None, :] + rot.astype(jnp.float32) * sin[None, :, None, :]
    return out.astype(t.dtype)


def diff_attention(q, k, v, lam, cos, sin):
    B, S = q.shape[0], q.shape[1]
    n_blk = S // Q_BLOCK
    q = apply_rope(q, cos, sin) * (DIFF_HEAD_DIM ** -0.5)
    k = apply_rope(k, cos, sin)
    q_blocks = q.reshape(B, n_blk, Q_BLOCK, 2 * N_DIFF_HEADS, DIFF_HEAD_DIM).transpose(1, 0, 3, 2, 4)
    kt = k.transpose(0, 2, 1, 3)
    vt = v.transpose(0, 2, 1, 3)
    k_chunk = jnp.arange(S, dtype=jnp.int32) // CHUNK
    q_chunk = k_chunk.reshape(n_blk, Q_BLOCK)

    def one_block(args):
        q_blk, qc = args
        s = jnp.einsum('bhqd,bhkd->bhqk', q_blk, kt, preferred_element_type=jnp.float32)
        mask = k_chunk[None, :] <= qc[:, None]
        p = jax.nn.softmax(jnp.where(mask, s, -jnp.inf), axis=-1)
        p = p.reshape(B, N_DIFF_HEADS, 2, Q_BLOCK, S)
        a = (p[:, :, 0] - lam * p[:, :, 1]).astype(vt.dtype)
        return jnp.einsum('bhqk,bhkd->bhqd', a, vt)

    o = lax.map(one_block, (q_blocks, q_chunk))
    return o.transpose(1, 0, 3, 2, 4).reshape(B, S, N_DIFF_HEADS, 2 * DIFF_HEAD_DIM)


def spatial_gating(z, ln_g, ln_b, w_s, b_s):
    B, S = z.shape[0], z.shape[1]
    n_c = S // GMLP_CHUNK
    u, vg = z[..., :GMLP_WIDTH], z[..., GMLP_WIDTH:]
    vg = vg.reshape(B, S, N_GMLP_GROUPS, GMLP_GROUP_DIM)
    vg = layer_norm(vg, ln_g.reshape(N_GMLP_GROUPS, GMLP_GROUP_DIM), ln_b.reshape(N_GMLP_GROUPS, GMLP_GROUP_DIM))
    vg = vg.reshape(B, n_c, GMLP_CHUNK, N_GMLP_GROUPS, GMLP_GROUP_DIM)
    w_causal = jnp.tril(w_s)
    gate = jnp.einsum('gts,bcsgd->bctgd', w_causal, vg) + b_s.T[None, None, :, :, None]
    u = u.reshape(B, n_c, GMLP_CHUNK, N_GMLP_GROUPS, GMLP_GROUP_DIM)
    return (u * gate).reshape(B, S, GMLP_WIDTH)


def causal_dwconv(h, w, b):
    S = h.shape[1]
    hp = jnp.pad(h, ((0, 0), (CONV_WIDTH - 1, 0), (0, 0)))
    y = b
    for j in range(CONV_WIDTH):
        y = y + w[j] * hp[:, j:j + S]
    return y


def setup_inputs(seed: int = 0) -> dict:
    key = jax.random.key(seed)
    ks = jax.random.split(key, 24)
    f32 = jnp.float32
    nrm = lambda k, shape, scale: jax.random.normal(k, shape, f32) * scale
    L = DEPTH
    return {
        "x": jax.random.normal(ks[0], (BATCH, SEQ, D_MODEL), f32),
        "w_in": nrm(ks[1], (L, D_MODEL, IN_WIDTH), D_MODEL ** -0.5),
        "lambda_q1": nrm(ks[2], (L, DIFF_HEAD_DIM), 0.1),
        "lambda_k1": nrm(ks[3], (L, DIFF_HEAD_DIM), 0.1),
        "lambda_q2": nrm(ks[4], (L, DIFF_HEAD_DIM), 0.1),
        "lambda_k2": nrm(ks[5], (L, DIFF_HEAD_DIM), 0.1),
        "subln_g": 1.0 + nrm(ks[6], (L, 2 * DIFF_HEAD_DIM), 0.02),
        "gmlp_ln_g": 1.0 + nrm(ks[7], (L, GMLP_WIDTH), 0.02),
        "gmlp_ln_b": nrm(ks[8], (L, GMLP_WIDTH), 0.02),
        "w_spatial": nrm(ks[9], (L, N_GMLP_GROUPS, GMLP_CHUNK, GMLP_CHUNK), GMLP_CHUNK ** -0.5),
        "b_spatial": 1.0 + nrm(ks[10], (L, N_GMLP_GROUPS, GMLP_CHUNK), 0.02),
        "w_out": nrm(ks[11], (L, D_MODEL, D_MODEL), D_MODEL ** -0.5 * DEEPNORM_BETA),
        "ln1_g": 1.0 + nrm(ks[12], (L, D_MODEL), 0.02),
        "ln1_b": nrm(ks[13], (L, D_MODEL), 0.02),
        "w_gate": nrm(ks[14], (L, D_MODEL, D_FF), D_MODEL ** -0.5),
        "w_up": nrm(ks[15], (L, D_MODEL, D_FF), D_MODEL ** -0.5),
        "conv_w": nrm(ks[16], (L, CONV_WIDTH, D_FF), CONV_WIDTH ** -0.5),
        "conv_b": nrm(ks[17], (L, D_FF), 0.02),
        "w_down": nrm(ks[18], (L, D_FF, D_MODEL), D_FF ** -0.5 * DEEPNORM_BETA),
        "ln2_g": 1.0 + nrm(ks[19], (L, D_MODEL), 0.02),
        "ln2_b": nrm(ks[20], (L, D_MODEL), 0.02),
    }


def reference(x, w_in, lambda_q1, lambda_k1, lambda_q2, lambda_k2, subln_g, gmlp_ln_g, gmlp_ln_b,
              w_spatial, b_spatial, w_out, ln1_g, ln1_b, w_gate, w_up, conv_w, conv_b, w_down,
              ln2_g, ln2_b):
    B, S, _ = x.shape
    cos, sin = rope_tables(S)
    for l in range(DEPTH):
        lambda_init = 0.8 - 0.6 * math.exp(-0.3 * l)
        h = jnp.einsum('bsd,de->bse', x, w_in[l])
        qa = h[..., :ATT_WIDTH].reshape(B, S, 2 * N_DIFF_HEADS, DIFF_HEAD_DIM)
        ka = h[..., ATT_WIDTH:2 * ATT_WIDTH].reshape(B, S, 2 * N_DIFF_HEADS, DIFF_HEAD_DIM)
        va = h[..., 2 * ATT_WIDTH:3 * ATT_WIDTH].reshape(B, S, N_DIFF_HEADS, 2 * DIFF_HEAD_DIM)
        zb = h[..., 3 * ATT_WIDTH:]

        lam = (jnp.exp(jnp.sum(lambda_q1[l].astype(jnp.float32) * lambda_k1[l].astype(jnp.float32)))
               - jnp.exp(jnp.sum(lambda_q2[l].astype(jnp.float32) * lambda_k2[l].astype(jnp.float32)))
               + lambda_init)
        oa = diff_attention(qa, ka, va, lam, cos, sin)
        oa = (rms_norm(oa, subln_g[l]) * (1.0 - lambda_init)).reshape(B, S, ATT_WIDTH)

        ob = spatial_gating(jax.nn.gelu(zb, approximate=False), gmlp_ln_g[l], gmlp_ln_b[l],
                            w_spatial[l], b_spatial[l])

        mix = jnp.einsum('bse,ed->bsd', jnp.concatenate([oa, ob], axis=-1), w_out[l])
        x = layer_norm(DEEPNORM_ALPHA * x + mix, ln1_g[l], ln1_b[l])

        g = jnp.einsum('bsd,df->bsf', x, w_gate[l])
        up = jnp.einsum('bsd,df->bsf', x, w_up[l])
        g = causal_dwconv(g, conv_w[l], conv_b[l])
        f = jnp.einsum('bsf,fd->bsd', jax.nn.silu(g) * up, w_down[l])
        x = layer_norm(DEEPNORM_ALPHA * x + f, ln2_g[l], ln2_b[l])
    return x
```

```cpp
#include <hip/hip_runtime.h>
#include <hip/hip_cooperative_groups.h>
#include <cstdio>
#include <cstdint>
namespace cg = cooperative_groups;
namespace pg8 {
#define PG8_LAS __attribute__((address_space(3)))
typedef unsigned short bf16_t;
typedef short bf16x8 __attribute__((ext_vector_type(8)));
typedef float f32x4 __attribute__((ext_vector_type(4)));
typedef unsigned u32x4 __attribute__((ext_vector_type(4)));
constexpr int BM = 256, BK = 64, HALF = 128, HTB = HALF * BK * 2  , STAGE_BYTES = 8 * HTB, NXCD = 8, WGM = 8;

__host__ __device__ __forceinline__ int lds_byte(int r, int c) { const int st = (r >> 4) * 2 + (c >> 5), rr = r & 15, cc = c & 31, ob = rr * 64 + cc * 2; return st * 1024 + (ob ^ (((ob >> 9) & 1) << 5)); }
__host__ __device__ __forceinline__ void stage_rc(int b, int& R, int& C) { const int st = b / 1024, sb = b % 1024, swz = sb ^ (((sb >> 9) & 1) << 5); R = (st >> 1) * 16 + swz / 64; C = (st & 1) * 32 + (swz % 64) / 2; }
__host__ __device__ __forceinline__ int perm32(int rho) { const int n = rho >> 4, i = rho & 15; return 8 * (i >> 2) + 4 * n + (i & 3); }

struct Unit { int pm, pn; };
struct Gemm { const bf16_t* A; const bf16_t* Bt; int M, N, K; };

struct StaticOrder {
    int nM, nN, nwg, G, c;
    __host__ __device__ void init(int M, int N, int G_, int c_) { nM = M / BM; nN = N / BM; nwg = nM * nN; G = G_; c = c_; }
    __host__ __device__ bool next(int i, Unit& u) const {
        const long L = (long)i * G + c; if (L >= nwg) return false;
        int wgid = (int)L; { const int q = nwg / NXCD, r = nwg % NXCD, xcd = wgid % NXCD, off = wgid / NXCD; wgid = (xcd < r ? xcd * (q + 1) : r * (q + 1) + (xcd - r) * q) + off; }
        const int nig = WGM * nN, gid = wgid / nig, fm = gid * WGM, gsz = (nM - fm) < WGM ? (nM - fm) : WGM;
        u.pm = fm + ((wgid % nig) % gsz); u.pn = (wgid % nig) / gsz; return true;
    }
    __device__ __forceinline__ void a_ready(const Unit&) const {}
    __device__ __forceinline__ void done(const Unit&) const {}
};

__device__ __forceinline__ unsigned cvt_pk_bf16(float lo, float hi) { unsigned r; asm volatile("v_cvt_pk_bf16_f32 %0, %1, %2" : "=v"(r) : "v"(lo), "v"(hi)); return r; }
typedef float f32x2 __attribute__((ext_vector_type(2)));
__device__ __forceinline__ f32x2 gelu_pk(f32x2 v) {
    const f32x2 av = __builtin_elementwise_abs(v), d = av * 0.2316418882f + 1.0f;
    f32x2 t; t.x = __builtin_amdgcn_rcpf(d.x); t.y = __builtin_amdgcn_rcpf(d.y);
    f32x2 q = t * 0.5307027145f + (-0.7265760135f); q = q * t + 0.7107068705f; q = q * t + (-0.142248368f); q = q * t + 0.127414796f; q = q * t;
    const f32x2 s = (v * v) * (-0.72134752044f);
    f32x2 e; e.x = __builtin_amdgcn_exp2f(s.x); e.y = __builtin_amdgcn_exp2f(s.y);
    const f32x2 m = v * (q * e), r = v - m;
    f32x2 o; o.x = v.x < 0.f ? m.x : r.x; o.y = v.y < 0.f ? m.y : r.y; return o;
}
template <class Epi, class Sched, bool ALIGN_EPI = false, bool SP2 = false>
__device__ __forceinline__ void gemm_phase(PG8_LAS unsigned char* lds, const Gemm g, const Sched& S, const Epi& E) {
    const int tid = threadIdx.x, wid = __builtin_amdgcn_readfirstlane(tid >> 6), lane = tid & 63, wr = wid >> 2, wc = wid & 3, fr = lane & 15, fq = lane >> 4;
    const int K = g.K, nt = K / BK;
    unsigned voffA[2], voffB[2];
#pragma unroll
    for (int i = 0; i < 2; ++i) { int R, C; stage_rc(tid * 16 + i * 8192, R, C); const int Rb = Epi::PERM ? ((R & ~31) + perm32(R & 31)) : R;
        voffA[i] = (unsigned)(R * K + C) * 2u; voffB[i] = (unsigned)(Rb * K + C) * 2u; }
    const size_t kstep = (size_t)(BK * 2);
    const size_t hstep = (size_t)HALF * K * 2;
    const size_t tstep = 2 * hstep;
    const unsigned ldsw = (unsigned)wid * 1024u;
    const int aoff = lds_byte(wr * 64 + fr, fq * 8), boff = lds_byte(wc * 32 + fr, fq * 8);
#define PG8_SA(b, h) (((b) * 2 + (h)) * HTB)
#define PG8_SB(b, h) ((4 + (b) * 2 + (h)) * HTB)
#define PG8_STAGE(bufoff, gbase, voff) do { _Pragma("unroll") for (int _i = 0; _i < 2; ++_i) \
        __builtin_amdgcn_global_load_lds((const unsigned*)((const char*)(gbase) + (voff)[_i]), (PG8_LAS unsigned*)(lds + (bufoff) + ldsw + _i * 8192), 16, 0, 0); } while (0)
#define PG8_LDA(dst, b, h) do { _Pragma("unroll") for (int m = 0; m < 4; ++m) _Pragma("unroll") for (int k = 0; k < 2; ++k) dst[m][k] = *(const PG8_LAS bf16x8*)(lds + PG8_SA(b, h) + aoff + m * 2048 + k * 1024); } while (0)
#define PG8_LDB(dst, b, h) do { _Pragma("unroll") for (int n = 0; n < 2; ++n) _Pragma("unroll") for (int k = 0; k < 2; ++k) dst[n][k] = *(const PG8_LAS bf16x8*)(lds + PG8_SB(b, h) + boff + n * 2048 + k * 1024); } while (0)
#define PG8_MMA(ai, bj, At, Bt) do { __builtin_amdgcn_s_setprio(1); _Pragma("unroll") for (int m = 0; m < 4; ++m) _Pragma("unroll") for (int n = 0; n < 2; ++n) _Pragma("unroll") for (int k = 0; k < 2; ++k) \
        acc[ai][bj][m][n] = __builtin_amdgcn_mfma_f32_16x16x32_bf16(Bt[n][k], At[m][k], acc[ai][bj][m][n], 0, 0, 0); __builtin_amdgcn_s_setprio(0); } while (0)
#define PG8_WAIT_V(n) asm volatile("s_waitcnt vmcnt(" #n ")" ::: "memory")
#define PG8_WAIT_L(n) asm volatile("s_waitcnt lgkmcnt(" #n ")" ::: "memory")
#define PG8_BAR __builtin_amdgcn_s_barrier()
#define PG8_SCHED __builtin_amdgcn_sched_barrier(0)
    Unit cur, nxt; int ui = 0;
    if (!S.next(0, cur)) return;
    f32x4 acc[2][2][4][2];
#pragma unroll
    for (int a = 0; a < 2; ++a)
#pragma unroll
        for (int b = 0; b < 2; ++b)
#pragma unroll
            for (int m = 0; m < 4; ++m)
#pragma unroll
                for (int n = 0; n < 2; ++n) acc[a][b][m][n] = (f32x4){0.f, 0.f, 0.f, 0.f};
    bf16x8 At[4][2], B0[2][2], B1[2][2];
    const char* cA = (const char*)g.A + (size_t)cur.pm * tstep; const char* cB = (const char*)g.Bt + (size_t)cur.pn * tstep;
    S.a_ready(cur);
    if constexpr (SP2) {
        PG8_STAGE(PG8_SB(0, 0), cB, voffB); PG8_STAGE(PG8_SB(0, 1), cB + hstep, voffB); PG8_STAGE(PG8_SA(0, 0), cA, voffA); PG8_STAGE(PG8_SA(0, 1), cA + hstep, voffA);
        if (wr == 1) PG8_BAR;
        PG8_WAIT_V(2); PG8_BAR;
        PG8_STAGE(PG8_SB(1, 0), cB + kstep, voffB); PG8_STAGE(PG8_SA(1, 0), cA + kstep, voffA); PG8_STAGE(PG8_SB(1, 1), cB + hstep + kstep, voffB);
        PG8_WAIT_V(6); PG8_BAR;
    } else {
        PG8_STAGE(PG8_SB(0, 0), cB, voffB); PG8_STAGE(PG8_SA(0, 0), cA, voffA); PG8_STAGE(PG8_SB(0, 1), cB + hstep, voffB); PG8_STAGE(PG8_SA(0, 1), cA + hstep, voffA);
        if (wr == 1) PG8_BAR;
        PG8_WAIT_V(4); PG8_BAR;
        PG8_STAGE(PG8_SB(1, 0), cB + kstep, voffB); PG8_STAGE(PG8_SA(1, 0), cA + kstep, voffA); PG8_STAGE(PG8_SB(1, 1), cB + hstep + kstep, voffB);
        PG8_WAIT_V(6); PG8_BAR;
    }
    for (;;) {
        const bool has_next = S.next(ui + 1, nxt);
        const char* nA = has_next ? (const char*)g.A + (size_t)nxt.pm * tstep : cA; const char* nB = has_next ? (const char*)g.Bt + (size_t)nxt.pn * tstep : cB;
        for (int t = 0; t < nt; t += 2) {
            const bool last = (t == nt - 2);
            const char* a1 = cA + (size_t)(t + 1) * kstep;
            const char* a2 = last ? nA : cA + (size_t)(t + 2) * kstep; const char* b2 = last ? nB : cB + (size_t)(t + 2) * kstep;
            const char* a3 = a2 + kstep; const char* b3 = b2 + kstep;
            if (last && has_next) S.a_ready(nxt);
            if constexpr (SP2) {
            PG8_LDB(B0, 0, 0); PG8_LDB(B1, 0, 1); PG8_SCHED; PG8_LDA(At, 0, 0); PG8_STAGE(PG8_SA(1, 1), a1 + hstep, voffA);
            PG8_WAIT_V(8); PG8_WAIT_L(0); PG8_BAR; PG8_MMA(0, 0, At, B0); PG8_MMA(0, 1, At, B1); PG8_BAR; PG8_SCHED;
            PG8_LDA(At, 0, 1); PG8_STAGE(PG8_SB(0, 0), b2, voffB); PG8_STAGE(PG8_SB(0, 1), b2 + hstep, voffB); PG8_STAGE(PG8_SA(0, 0), a2, voffA);
            PG8_WAIT_V(8); PG8_WAIT_L(0); PG8_BAR; PG8_MMA(1, 0, At, B0); PG8_MMA(1, 1, At, B1); PG8_BAR; PG8_SCHED;
            PG8_LDB(B0, 1, 0); PG8_LDB(B1, 1, 1); PG8_SCHED; PG8_LDA(At, 1, 0); PG8_STAGE(PG8_SA(0, 1), a2 + hstep, voffA);
            PG8_WAIT_V(8); PG8_WAIT_L(0); PG8_BAR; PG8_MMA(0, 0, At, B0); PG8_MMA(0, 1, At, B1); PG8_BAR; PG8_SCHED;
            PG8_LDA(At, 1, 1); PG8_STAGE(PG8_SB(1, 0), b3, voffB); PG8_STAGE(PG8_SB(1, 1), b3 + hstep, voffB); PG8_STAGE(PG8_SA(1, 0), a3, voffA);
            PG8_WAIT_V(8); PG8_WAIT_L(0); PG8_BAR; PG8_MMA(1, 0, At, B0); PG8_MMA(1, 1, At, B1); PG8_BAR; PG8_SCHED;
            } else {
            PG8_LDB(B0, 0, 0); PG8_SCHED; PG8_LDA(At, 0, 0); PG8_STAGE(PG8_SA(1, 1), a1 + hstep, voffA);
            PG8_WAIT_L(8); PG8_BAR; PG8_WAIT_L(0); PG8_MMA(0, 0, At, B0); PG8_BAR; PG8_SCHED;
            PG8_LDB(B1, 0, 1); PG8_STAGE(PG8_SB(0, 0), b2, voffB);
            PG8_BAR; PG8_WAIT_L(0); PG8_MMA(0, 1, At, B1); PG8_BAR;
            PG8_LDA(At, 0, 1); PG8_STAGE(PG8_SA(0, 0), a2, voffA);
            PG8_BAR; PG8_WAIT_L(0); PG8_MMA(1, 0, At, B0); PG8_BAR; PG8_SCHED;
            PG8_STAGE(PG8_SB(0, 1), b2 + hstep, voffB);
            PG8_WAIT_V(6); PG8_BAR; PG8_MMA(1, 1, At, B1); PG8_BAR;
            PG8_LDB(B0, 1, 0); PG8_SCHED; PG8_LDA(At, 1, 0); PG8_STAGE(PG8_SA(0, 1), a2 + hstep, voffA);
            PG8_WAIT_L(8); PG8_BAR; PG8_WAIT_L(0); PG8_MMA(0, 0, At, B0); PG8_BAR; PG8_SCHED;
            PG8_LDB(B1, 1, 1); PG8_STAGE(PG8_SB(1, 0), b3, voffB);
            PG8_BAR; PG8_WAIT_L(0); PG8_MMA(0, 1, At, B1); PG8_BAR;
            PG8_LDA(At, 1, 1); PG8_STAGE(PG8_SA(1, 0), a3, voffA);
            PG8_BAR; PG8_WAIT_L(0); PG8_MMA(1, 0, At, B0); PG8_BAR; PG8_SCHED;
            PG8_STAGE(PG8_SB(1, 1), b3 + hstep, voffB);
            PG8_WAIT_V(6); PG8_BAR; PG8_MMA(1, 1, At, B1); PG8_BAR;
            }
        }
        if constexpr (ALIGN_EPI) { if (wr == 0) PG8_BAR; }
        if constexpr (!Epi::AFTER_DRAIN) { E(acc, cur, wr, wc, fr, fq); S.done(cur); }
        if (!has_next) break;
#pragma unroll
        for (int a = 0; a < 2; ++a)
#pragma unroll
            for (int b = 0; b < 2; ++b)
#pragma unroll
                for (int m = 0; m < 4; ++m)
#pragma unroll
                    for (int n = 0; n < 2; ++n) acc[a][b][m][n] = (f32x4){0.f, 0.f, 0.f, 0.f};
        cur = nxt; cA = nA; cB = nB; ++ui;
        if constexpr (ALIGN_EPI) { if (wr == 1) PG8_BAR; }
    }
    PG8_WAIT_V(0);
    if constexpr (!ALIGN_EPI) { if (wr == 0) PG8_BAR; }
    PG8_BAR;
    if constexpr (Epi::AFTER_DRAIN) { E.fused(acc, cur, wr, wc, fr, fq, lds, wid, lane); S.done(cur); }
#undef PG8_SA
#undef PG8_SB
#undef PG8_STAGE
#undef PG8_LDA
#undef PG8_LDB
#undef PG8_MMA
#undef PG8_WAIT_V
#undef PG8_WAIT_L
#undef PG8_BAR
#undef PG8_SCHED
}
}

#ifndef MK_N_LAUNCHES
#define MK_N_LAUNCHES 1
#endif
constexpr int BATCH = 4, SEQ = 8192, DM = 1024, M = BATCH * SEQ, NIN = 2560, FF = 2816, NGU = 2 * FF, QKVP = 1536;
constexpr float LN_EPS = 1e-5f;
constexpr float ALPHA = 1.189207115002721f;
constexpr float C2 = 0.125f * 1.4426950408889634f;
constexpr int NPHASE = 9;
constexpr size_t MiB = 1u << 20;
constexpr size_t WS_WIN = 1 * MiB, WS_WO = 6 * MiB, WS_WGU = 8 * MiB, WS_WD = 19 * MiB, WS_ROPE = 25 * MiB, WS_TRIL = 27 * MiB, WS_X1B = 28 * MiB;
constexpr size_t WS_BIG = 92 * MiB;
constexpr size_t WS_XB = WS_BIG, WS_QKV = WS_BIG + 64 * MiB, WS_Z = WS_BIG + 160 * MiB, WS_CAT = WS_BIG + 224 * MiB;
constexpr size_t WS_G = WS_BIG, WS_U = WS_BIG + 176 * MiB, WS_END = WS_BIG + 352 * MiB;
constexpr int LDS_BYTES = 147456;

#define LAS __attribute__((address_space(3)))
typedef unsigned short bf16_t;
typedef short bf16x8 __attribute__((ext_vector_type(8)));
typedef short s16x4 __attribute__((ext_vector_type(4)));
typedef float f32x4 __attribute__((ext_vector_type(4)));
typedef float f32x2 __attribute__((ext_vector_type(2)));
typedef unsigned u32x4 __attribute__((ext_vector_type(4)));
typedef unsigned u32x2 __attribute__((ext_vector_type(2)));
using pg8::cvt_pk_bf16;
using pg8::Unit;

__device__ __forceinline__ float wave_sum(float v) {
#pragma unroll
    for (int o = 1; o < 64; o <<= 1) v += __shfl_xor(v, o);
    return v;
}
__device__ __forceinline__ float bf2f(unsigned short h) { return __uint_as_float((unsigned)h << 16); }
__device__ __forceinline__ float bflo(unsigned w) { return __uint_as_float(w << 16); }
__device__ __forceinline__ float bfhi(unsigned w) { return __uint_as_float(w & 0xffff0000u); }

struct EpiIn {
    static constexpr bool PERM = true, AFTER_DRAIN = false;
    bf16_t* QKV; bf16_t* Z; const float* rope;
    __device__ __forceinline__ void operator()(const f32x4 (&acc)[2][2][4][2], const Unit& u, int wr, int wc, int fr, int fq) const {
        const int row0 = u.pm * 256 + wr * 64 + fr, colt = u.pn * 256;
#pragma unroll
        for (int ai = 0; ai < 2; ++ai)
#pragma unroll
            for (int m = 0; m < 4; ++m) {
                const int row = row0 + ai * 128 + m * 16;
#pragma unroll
                for (int bj = 0; bj < 2; ++bj) {
                    const int c0 = colt + bj * 128 + wc * 32 + 8 * fq;
                    f32x4 v0 = acc[ai][bj][m][0], v1 = acc[ai][bj][m][1];
                    if (colt < 1024) {
                        const int d = (c0 & 63) >> 1, pos = row & (SEQ - 1);
                        const f32x4 cs = *(const f32x4*)(rope + pos * 64 + d), sn = *(const f32x4*)(rope + pos * 64 + 32 + d);
                        f32x4 lo = v0 * cs - v1 * sn, hi = v1 * cs + v0 * sn;
                        if (colt < 512) { lo = lo * C2; hi = hi * C2; }
                        bf16_t* p = QKV + (size_t)row * QKVP + (c0 & ~63) + d;
                        u32x2 a, b; a.x = cvt_pk_bf16(lo[0], lo[1]); a.y = cvt_pk_bf16(lo[2], lo[3]); b.x = cvt_pk_bf16(hi[0], hi[1]); b.y = cvt_pk_bf16(hi[2], hi[3]);
                        *(u32x2*)p = a; *(u32x2*)(p + 32) = b;
                    } else if (colt < 1536) {
                        u32x4 w; w.x = cvt_pk_bf16(v0[0], v0[1]); w.y = cvt_pk_bf16(v0[2], v0[3]); w.z = cvt_pk_bf16(v1[0], v1[1]); w.w = cvt_pk_bf16(v1[2], v1[3]);
                        *(u32x4*)(QKV + (size_t)row * QKVP + c0) = w;
                    } else {
                        const pg8::f32x2 a = pg8::gelu_pk((pg8::f32x2){v0[0], v0[1]}), b = pg8::gelu_pk((pg8::f32x2){v0[2], v0[3]}), c = pg8::gelu_pk((pg8::f32x2){v1[0], v1[1]}), e = pg8::gelu_pk((pg8::f32x2){v1[2], v1[3]});
                        u32x4 w; w.x = cvt_pk_bf16(a.x, a.y); w.y = cvt_pk_bf16(b.x, b.y); w.z = cvt_pk_bf16(c.x, c.y); w.w = cvt_pk_bf16(e.x, e.y);
                        *(u32x4*)(Z + (size_t)row * 1024 + (c0 - 1536)) = w;
                    }
                }
            }
    }
};
struct EpiRes {
    static constexpr bool PERM = false, AFTER_DRAIN = false;
    const float* base; float* out;
    __device__ __forceinline__ void operator()(const f32x4 (&acc)[2][2][4][2], const Unit& u, int wr, int wc, int fr, int fq) const {
        const int row0 = u.pm * 256 + wr * 64 + fr, col0 = u.pn * 256 + wc * 32 + 4 * fq;
#pragma unroll
        for (int ai = 0; ai < 2; ++ai)
#pragma unroll
            for (int m = 0; m < 4; ++m) {
                const size_t off = (size_t)(row0 + ai * 128 + m * 16) * DM + col0;
#pragma unroll
                for (int bj = 0; bj < 2; ++bj)
#pragma unroll
                    for (int n = 0; n < 2; ++n) { const f32x4 bs = *(const f32x4*)(base + off + bj * 128 + n * 16); *(f32x4*)(out + off + bj * 128 + n * 16) = bs * ALPHA + acc[ai][bj][m][n]; }
            }
    }
};
struct EpiGU {
    static constexpr bool PERM = true, AFTER_DRAIN = false;
    bf16_t* G; bf16_t* U;
    __device__ __forceinline__ void operator()(const f32x4 (&acc)[2][2][4][2], const Unit& u, int wr, int wc, int fr, int fq) const {
        const int row0 = u.pm * 256 + wr * 64 + fr, f0 = u.pn * 128 + wc * 32 + 8 * fq;
#pragma unroll
        for (int ai = 0; ai < 2; ++ai)
#pragma unroll
            for (int m = 0; m < 4; ++m) {
                const size_t off = (size_t)(row0 + ai * 128 + m * 16) * FF + f0;
#pragma unroll
                for (int bj = 0; bj < 2; ++bj) {
                    const f32x4 v0 = acc[ai][bj][m][0], v1 = acc[ai][bj][m][1];
                    u32x4 w; w.x = cvt_pk_bf16(v0[0], v0[1]); w.y = cvt_pk_bf16(v0[2], v0[3]); w.z = cvt_pk_bf16(v1[0], v1[1]); w.w = cvt_pk_bf16(v1[2], v1[3]);
                    *(u32x4*)((bj ? U : G) + off) = w;
                }
            }
    }
};

__device__ __forceinline__ unsigned f2bf(float f) { unsigned u = __builtin_bit_cast(unsigned, f); return (u + 0x7fffu + ((u >> 16) & 1u)) >> 16; }
__device__ __forceinline__ unsigned pk2(float lo, float hi) { return f2bf(lo) | (f2bf(hi) << 16); }
template <int MODE> __device__ __forceinline__ const float* wsrc(const float* W, const float* W2, int j, int& N) {
    if (MODE == 1) { if (j < 1024) { const int jj = j & 63; j = (j - jj) + 32 * ((jj >> 2) & 1) + 4 * (jj >> 3) + (jj & 3); } return W + j; }
    if (MODE == 2) { const int pn = j >> 8, bj = (j >> 7) & 1, f = (pn << 7) + (j & 127); return (bj ? W2 : W) + f; }
    return W + j;
}
template <int MODE> __device__ __forceinline__ void transpose_item(const float* W, const float* W2, int K, int N, int NOUT, bf16_t* WT, LAS float* scr, int item, int lane) {
    const int nblk = NOUT / 32, kb = item / nblk, nb = item % nblk, k0 = 64 * kb, n0 = 32 * nb;
    int Nn = N; const float* src = wsrc<MODE>(W, W2, n0 + (lane & 31), Nn);
#pragma unroll 8
    for (int i = 0; i < 32; ++i) { const int kk = 2 * i + (lane >> 5); scr[kk * 33 + (lane & 31)] = src[(size_t)(k0 + kk) * N]; }
    asm volatile("s_waitcnt lgkmcnt(0)" ::: "memory");
    const int c = lane & 7;
#pragma unroll
    for (int j = 0; j < 4; ++j) { const int n = (lane >> 3) + 8 * j; const LAS float* s = scr + (8 * c) * 33 + n;
        u32x4 o; o.x = pk2(s[0 * 33], s[1 * 33]); o.y = pk2(s[2 * 33], s[3 * 33]); o.z = pk2(s[4 * 33], s[5 * 33]); o.w = pk2(s[6 * 33], s[7 * 33]);
        *(u32x4*)(WT + (size_t)(n0 + n) * K + k0 + 8 * c) = o; }
    asm volatile("s_waitcnt lgkmcnt(0)" ::: "memory");
}
__device__ __forceinline__ void ln_row(const float* in, float* outf, bf16_t* outb, const float* g, const float* b, int lane) {
    const f32x4* xr = (const f32x4*)in + lane;
    f32x4 v[4]; float s = 0.f;
#pragma unroll
    for (int j = 0; j < 4; ++j) { v[j] = xr[64 * j]; s += (v[j].x + v[j].y) + (v[j].z + v[j].w); }
    const float mean = wave_sum(s) * (1.f / DM); float s2 = 0.f;
#pragma unroll
    for (int j = 0; j < 4; ++j) { v[j] = v[j] - mean; s2 += (v[j].x * v[j].x + v[j].y * v[j].y) + (v[j].z * v[j].z + v[j].w * v[j].w); }
    const float rstd = 1.f / sqrtf(wave_sum(s2) * (1.f / DM) + LN_EPS);
#pragma unroll
    for (int j = 0; j < 4; ++j) {
        const f32x4 gv = ((const f32x4*)g)[lane + 64 * j], bv = ((const f32x4*)b)[lane + 64 * j];
        const f32x4 y = v[j] * rstd * gv + bv;
        if (outf) ((f32x4*)outf)[lane + 64 * j] = y;
        if (outb) { u32x2 w; w.x = cvt_pk_bf16(y.x, y.y); w.y = cvt_pk_bf16(y.z, y.w); ((u32x2*)outb)[lane + 64 * j] = w; }
    }
}

namespace att {
constexpr int KB = 8192, VSTR = 288, VB = 64 * VSTR, BUF = 2 * KB + VB;
__device__ __forceinline__ s16x4 vtr(const LAS unsigned char* p) { return __builtin_bit_cast(s16x4, __builtin_amdgcn_ds_read_tr16_b64_v4i16((LAS s16x4*)p)); }

__device__ __forceinline__ void softmax_tile(f32x4 (&s)[4], float& m, float& l, f32x4 (&O)[8], bf16x8 (&P)[2]) {
    float mx = fmaxf(fmaxf(s[0][0], s[0][1]), fmaxf(s[0][2], s[0][3]));
#pragma unroll
    for (int T = 1; T < 4; ++T) mx = fmaxf(mx, fmaxf(fmaxf(s[T][0], s[T][1]), fmaxf(s[T][2], s[T][3])));
    mx = fmaxf(mx, __shfl_xor(mx, 16)); mx = fmaxf(mx, __shfl_xor(mx, 32));
    const float mn = fmaxf(m, mx);
    if (__any(mn > m)) {
        const float a = __builtin_amdgcn_exp2f(m - mn); l *= a;
#pragma unroll
        for (int t = 0; t < 8; ++t) O[t] = O[t] * a;
        m = mn;
    }
    float sum = 0.f; unsigned w[8];
#pragma unroll
    for (int T = 0; T < 4; ++T) {
        const float p0 = __builtin_amdgcn_exp2f(s[T][0] - m), p1 = __builtin_amdgcn_exp2f(s[T][1] - m), p2 = __builtin_amdgcn_exp2f(s[T][2] - m), p3 = __builtin_amdgcn_exp2f(s[T][3] - m);
        sum += (p0 + p1) + (p2 + p3); w[2 * T] = cvt_pk_bf16(p0, p1); w[2 * T + 1] = cvt_pk_bf16(p2, p3);
    }
    l += sum;
    P[0] = __builtin_bit_cast(bf16x8, (u32x4){w[0], w[1], w[2], w[3]});
    P[1] = __builtin_bit_cast(bf16x8, (u32x4){w[4], w[5], w[6], w[7]});
}

__device__ __forceinline__ void unit(LAS unsigned char* lds, const bf16_t* QKV, bf16_t* CAT, const float* subg, float lam, int b, int h, int u) {
    const int tid = threadIdx.x, lane = tid & 63, wid = __builtin_amdgcn_readfirstlane(tid >> 6), l15 = lane & 15, quad = lane >> 4;
    const size_t rowbase = (size_t)b * SEQ;
    const int q0 = 128 * u + 16 * wid, mychunk = q0 >> 6, NT = 2 * u + 2;
    const bf16_t* qp = QKV + (rowbase + q0 + l15) * QKVP + (2 * h) * 64 + 8 * quad;
    bf16x8 q1[2], q2[2];
    q1[0] = *(const bf16x8*)(qp); q1[1] = *(const bf16x8*)(qp + 32); q2[0] = *(const bf16x8*)(qp + 64); q2[1] = *(const bf16x8*)(qp + 96);
    const int skey = tid >> 3, spart = tid & 7, vkey = tid >> 4, vpart = tid & 15;
    const bf16_t* kg = QKV + (rowbase + skey) * QKVP + 512 + (2 * h) * 64 + spart * 8;
    const bf16_t* vg = QKV + (rowbase + vkey) * QKVP + 1024 + h * 128 + vpart * 8;
    const unsigned kl = skey * 128 + 16 * (spart ^ (skey & 7)), vl = 2 * KB + vkey * VSTR + vpart * 16;
    u32x4 rk1, rk2, rv0, rv1;
#define ATT_GLOAD(j) do { const size_t o_ = (size_t)(j) * 64 * QKVP; rk1 = *(const u32x4*)(kg + o_); rk2 = *(const u32x4*)(kg + o_ + 64); rv0 = *(const u32x4*)(vg + o_); rv1 = *(const u32x4*)(vg + o_ + 32 * QKVP); } while (0)
#define ATT_LSTORE(bufi) do { LAS unsigned char* B_ = lds + (bufi) * BUF; *(LAS u32x4*)(B_ + kl) = rk1; *(LAS u32x4*)(B_ + KB + kl) = rk2; *(LAS u32x4*)(B_ + vl) = rv0; *(LAS u32x4*)(B_ + vl + 32 * VSTR) = rv1; } while (0)
    f32x4 O1[8], O2[8];
#pragma unroll
    for (int t = 0; t < 8; ++t) { O1[t] = (f32x4){0.f, 0.f, 0.f, 0.f}; O2[t] = (f32x4){0.f, 0.f, 0.f, 0.f}; }
    float m1 = -INFINITY, m2 = -INFINITY, l1 = 0.f, l2 = 0.f;
    const unsigned koff0 = l15 * 128 + 16 * (quad ^ (l15 & 7)), koff1 = l15 * 128 + 16 * ((4 + quad) ^ (l15 & 7));
    const unsigned voff = 2 * KB + (4 * quad + (l15 >> 2)) * VSTR + (l15 & 3) * 8;
    ATT_GLOAD(0); ATT_LSTORE(0); __syncthreads();
    for (int j = 0; j < NT; ++j) {
        if (j + 1 < NT) ATT_GLOAD(j + 1);
        if (j <= mychunk) {
            const LAS unsigned char* B = lds + (j & 1) * BUF;
            f32x4 s1[4], s2[4];
#pragma unroll
            for (int T = 0; T < 4; ++T) {
                const bf16x8 a0 = *(const LAS bf16x8*)(B + T * 2048 + koff0), a1 = *(const LAS bf16x8*)(B + T * 2048 + koff1);
                const bf16x8 c0 = *(const LAS bf16x8*)(B + KB + T * 2048 + koff0), c1 = *(const LAS bf16x8*)(B + KB + T * 2048 + koff1);
                f32x4 z = (f32x4){0.f, 0.f, 0.f, 0.f};
                s1[T] = __builtin_amdgcn_mfma_f32_16x16x32_bf16(a0, q1[0], z, 0, 0, 0); s1[T] = __builtin_amdgcn_mfma_f32_16x16x32_bf16(a1, q1[1], s1[T], 0, 0, 0);
                s2[T] = __builtin_amdgcn_mfma_f32_16x16x32_bf16(c0, q2[0], z, 0, 0, 0); s2[T] = __builtin_amdgcn_mfma_f32_16x16x32_bf16(c1, q2[1], s2[T], 0, 0, 0);
            }
            bf16x8 P1[2], P2[2];
            softmax_tile(s1, m1, l1, O1, P1);
            softmax_tile(s2, m2, l2, O2, P2);
#pragma unroll
            for (int Td = 0; Td < 8; ++Td)
#pragma unroll
                for (int ks = 0; ks < 2; ++ks) {
                    const s16x4 lo = vtr(B + voff + (32 * ks) * VSTR + 32 * Td), hi = vtr(B + voff + (32 * ks + 16) * VSTR + 32 * Td);
                    const bf16x8 vf = (bf16x8){lo[0], lo[1], lo[2], lo[3], hi[0], hi[1], hi[2], hi[3]};
                    O1[Td] = __builtin_amdgcn_mfma_f32_16x16x32_bf16(vf, P1[ks], O1[Td], 0, 0, 0);
                    O2[Td] = __builtin_amdgcn_mfma_f32_16x16x32_bf16(vf, P2[ks], O2[Td], 0, 0, 0);
                }
        }
        if (j + 1 < NT) ATT_LSTORE((j + 1) & 1);
        __syncthreads();
    }
#undef ATT_GLOAD
#undef ATT_LSTORE
    l1 += __shfl_xor(l1, 16); l1 += __shfl_xor(l1, 32); l2 += __shfl_xor(l2, 16); l2 += __shfl_xor(l2, 32);
    const float r1 = 1.f / l1, r2 = lam / l2; float ss = 0.f;
#pragma unroll
    for (int t = 0; t < 8; ++t) { O1[t] = O1[t] * r1 - O2[t] * r2; ss += (O1[t][0] * O1[t][0] + O1[t][1] * O1[t][1]) + (O1[t][2] * O1[t][2] + O1[t][3] * O1[t][3]); }
    ss += __shfl_xor(ss, 16); ss += __shfl_xor(ss, 32);
    const float rn = 0.8f / sqrtf(ss * (1.f / 128.f) + LN_EPS);
    bf16_t* op = CAT + (rowbase + q0 + l15) * DM + h * 128 + 4 * quad;
#pragma unroll
    for (int t = 0; t < 8; ++t) { const f32x4 gv = *(const f32x4*)(subg + 16 * t + 4 * quad); const f32x4 y = O1[t] * rn * gv;
        u32x2 w; w.x = cvt_pk_bf16(y[0], y[1]); w.y = cvt_pk_bf16(y[2], y[3]); *(u32x2*)(op + 16 * t) = w; }
}
}

namespace gm {
constexpr int VSTR = 288;
__device__ __forceinline__ void unit(LAS unsigned char* lds, const bf16_t* Z, bf16_t* CAT, const bf16_t* TRIL, const float* lng, const float* lnb, const float* bs, int b, int c, int g) {
    const int tid = threadIdx.x, lane = tid & 63, wid = __builtin_amdgcn_readfirstlane(tid >> 6), l15 = lane & 15, quad = lane >> 4;
    const size_t row0 = (size_t)b * SEQ + 128 * c;
    {
        const int s = tid >> 2, seg = tid & 3;
        const bf16_t* zp = Z + (row0 + s) * 1024 + 512 + 128 * g + 32 * seg;
        float v[32];
#pragma unroll
        for (int i = 0; i < 4; ++i) { const u32x4 w = *(const u32x4*)(zp + 8 * i);
            v[8 * i + 0] = bflo(w.x); v[8 * i + 1] = bfhi(w.x); v[8 * i + 2] = bflo(w.y); v[8 * i + 3] = bfhi(w.y); v[8 * i + 4] = bflo(w.z); v[8 * i + 5] = bfhi(w.z); v[8 * i + 6] = bflo(w.w); v[8 * i + 7] = bfhi(w.w); }
        float sm = 0.f;
#pragma unroll
        for (int i = 0; i < 32; ++i) sm += v[i];
        sm += __shfl_xor(sm, 1); sm += __shfl_xor(sm, 2);
        const float mean = sm * (1.f / 128.f); float q = 0.f;
#pragma unroll
        for (int i = 0; i < 32; ++i) { v[i] -= mean; q += v[i] * v[i]; }
        q += __shfl_xor(q, 1); q += __shfl_xor(q, 2);
        const float rstd = 1.f / sqrtf(q * (1.f / 128.f) + LN_EPS);
        const float* gp = lng + 128 * g + 32 * seg; const float* bp = lnb + 128 * g + 32 * seg;
#pragma unroll
        for (int i = 0; i < 4; ++i) {
            const f32x4 g0 = *(const f32x4*)(gp + 8 * i), g1 = *(const f32x4*)(gp + 8 * i + 4), b0 = *(const f32x4*)(bp + 8 * i), b1 = *(const f32x4*)(bp + 8 * i + 4);
            u32x4 w;
            w.x = cvt_pk_bf16(v[8 * i + 0] * rstd * g0[0] + b0[0], v[8 * i + 1] * rstd * g0[1] + b0[1]);
            w.y = cvt_pk_bf16(v[8 * i + 2] * rstd * g0[2] + b0[2], v[8 * i + 3] * rstd * g0[3] + b0[3]);
            w.z = cvt_pk_bf16(v[8 * i + 4] * rstd * g1[0] + b1[0], v[8 * i + 5] * rstd * g1[1] + b1[1]);
            w.w = cvt_pk_bf16(v[8 * i + 6] * rstd * g1[2] + b1[2], v[8 * i + 7] * rstd * g1[3] + b1[3]);
            *(LAS u32x4*)(lds + s * VSTR + (32 * seg + 8 * i) * 2) = w;
        }
    }
    __syncthreads();
    const int t = 16 * wid + l15;
    f32x4 acc[8];
#pragma unroll
    for (int i = 0; i < 8; ++i) acc[i] = (f32x4){0.f, 0.f, 0.f, 0.f};
    const bf16_t* wp = TRIL + ((size_t)(g * 128 + t)) * 128 + 8 * quad;
    const unsigned voff = (8 * quad + (l15 >> 2)) * VSTR + (l15 & 3) * 8;
#pragma unroll
    for (int ks = 0; ks < 4; ++ks) {
        if (32 * ks <= 16 * wid + 15) {
            const bf16x8 wf = *(const bf16x8*)(wp + 32 * ks);
#pragma unroll
            for (int Td = 0; Td < 8; ++Td) {
                const s16x4 lo = att::vtr(lds + voff + (32 * ks) * VSTR + 32 * Td), hi = att::vtr(lds + voff + (32 * ks + 4) * VSTR + 32 * Td);
                const bf16x8 vf = (bf16x8){lo[0], lo[1], lo[2], lo[3], hi[0], hi[1], hi[2], hi[3]};
                acc[Td] = __builtin_amdgcn_mfma_f32_16x16x32_bf16(vf, wf, acc[Td], 0, 0, 0);
            }
        }
    }
    const float bt = bs[g * 128 + t];
    const bf16_t* up = Z + (row0 + t) * 1024 + 128 * g + 4 * quad;
    bf16_t* op = CAT + (row0 + t) * DM + 512 + 128 * g + 4 * quad;
#pragma unroll
    for (int Td = 0; Td < 8; ++Td) {
        const u32x2 uw = *(const u32x2*)(up + 16 * Td);
        u32x2 w; w.x = cvt_pk_bf16(bflo(uw.x) * (acc[Td][0] + bt), bfhi(uw.x) * (acc[Td][1] + bt)); w.y = cvt_pk_bf16(bflo(uw.y) * (acc[Td][2] + bt), bfhi(uw.y) * (acc[Td][3] + bt));
        *(u32x2*)(op + 16 * Td) = w;
    }
    __syncthreads();
}
}

struct Args { const float* in[21]; float* out; unsigned char* ws; int ph_lo, ph_hi; };
enum { I_X = 0, I_WIN, I_LQ1, I_LK1, I_LQ2, I_LK2, I_SUBG, I_GLNG, I_GLNB, I_WSP, I_BSP, I_WOUT, I_LN1G, I_LN1B, I_WGATE, I_WUP, I_CONVW, I_CONVB, I_WDOWN, I_LN2G, I_LN2B };

__global__ void __launch_bounds__(512, 2) fwd(Args a) {
    extern __shared__ __attribute__((aligned(16))) unsigned char lds_raw[];
    LAS unsigned char* lds = (LAS unsigned char*)lds_raw;
    cg::grid_group grid = cg::this_grid();
    const int tid = threadIdx.x, lane = tid & 63, wave = __builtin_amdgcn_readfirstlane(tid >> 6);
    const int G = gridDim.x, bx = blockIdx.x;
    const int vcu = (G % 8 == 0) ? (bx % 8) * (G / 8) + bx / 8 : bx;
    unsigned char* ws = a.ws;
    bf16_t* WinT = (bf16_t*)(ws + WS_WIN); bf16_t* WoT = (bf16_t*)(ws + WS_WO); bf16_t* WguT = (bf16_t*)(ws + WS_WGU); bf16_t* WdT = (bf16_t*)(ws + WS_WD);
    float* ROPE = (float*)(ws + WS_ROPE); bf16_t* TRIL = (bf16_t*)(ws + WS_TRIL); bf16_t* X1B = (bf16_t*)(ws + WS_X1B);
    bf16_t* XB = (bf16_t*)(ws + WS_XB); bf16_t* QKV = (bf16_t*)(ws + WS_QKV); bf16_t* Zb = (bf16_t*)(ws + WS_Z); bf16_t* CAT = (bf16_t*)(ws + WS_CAT);
    bf16_t* Gb = (bf16_t*)(ws + WS_G); bf16_t* Ub = (bf16_t*)(ws + WS_U);
    const int lo = a.ph_lo, hi = a.ph_hi;
#define IN(k) (lo <= (k) && (k) < hi)
#define SEAM(k) do { if (IN(k) && IN((k) + 1)) grid.sync(); } while (0)

    if (IN(0)) {
        LAS float* scr = (LAS float*)(lds + wave * 16384);
        const int gw = vcu * 8 + wave, NGW = G * 8;
        constexpr int I_IN = (DM / 64) * (NIN / 32), I_O = (DM / 64) * (DM / 32), I_GU = (DM / 64) * (NGU / 32), I_D = (FF / 64) * (DM / 32);
        for (int it = gw; it < I_IN + I_O + I_GU + I_D; it += NGW) {
            int r = it;
            if (r < I_IN) { transpose_item<1>(a.in[I_WIN], nullptr, DM, NIN, NIN, WinT, scr, r, lane); continue; } r -= I_IN;
            if (r < I_O) { transpose_item<0>(a.in[I_WOUT], nullptr, DM, DM, DM, WoT, scr, r, lane); continue; } r -= I_O;
            if (r < I_GU) { transpose_item<2>(a.in[I_WGATE], a.in[I_WUP], DM, FF, NGU, WguT, scr, r, lane); continue; } r -= I_GU;
            transpose_item<0>(a.in[I_WDOWN], nullptr, FF, DM, DM, WdT, scr, r, lane);
        }
        const size_t gt = (size_t)bx * 512 + tid, NTH = (size_t)G * 512;
        for (size_t i = gt; i < (size_t)M * DM / 4; i += NTH) { const f32x4 v = ((const f32x4*)a.in[I_X])[i]; u32x2 w; w.x = cvt_pk_bf16(v.x, v.y); w.y = cvt_pk_bf16(v.z, v.w); ((u32x2*)XB)[i] = w; }
        for (size_t i = gt; i < (size_t)SEQ * 32; i += NTH) {
            const int pos = (int)(i >> 5), k = (int)(i & 31);
            const float inv = 1.0f / powf(10000.0f, (float)k * (1.0f / 32.0f));
            const float ang = (float)pos * inv;
            const double tw = 6.283185307179586476925; const double ad = (double)ang; const double n = __builtin_rint(ad * (1.0 / tw)); const float r = (float)(ad - n * tw);
            ROPE[pos * 64 + k] = cosf(r); ROPE[pos * 64 + 32 + k] = sinf(r);
        }
        for (size_t i = gt; i < (size_t)4 * 128 * 128; i += NTH) { const int s = (int)(i & 127), t = (int)((i >> 7) & 127); TRIL[i] = (bf16_t)f2bf(s <= t ? a.in[I_WSP][i] : 0.f); }
    }
    SEAM(0);
    if (IN(1)) {
        pg8::Gemm g{XB, WinT, M, NIN, DM}; pg8::StaticOrder S; S.init(M, NIN, G, bx);
        EpiIn E{QKV, Zb, ROPE};
        pg8::gemm_phase<EpiIn, pg8::StaticOrder, true, true>(lds, g, S, E);
    }
    SEAM(1);
    if (IN(2)) {
        float d1 = 0.f, d2 = 0.f;
        for (int i = 0; i < 64; ++i) { d1 += a.in[I_LQ1][i] * a.in[I_LK1][i]; d2 += a.in[I_LQ2][i] * a.in[I_LK2][i]; }
        const float lam = expf(d1) - expf(d2) + 0.2f;
        for (int sl = vcu; sl < 256; sl += G) {
            const int bh = sl >> 4, s = sl & 15;
            for (int i = 0; i < 4; ++i) { const int u = (i == 0) ? s : (i == 1) ? 31 - s : (i == 2) ? 32 + s : 63 - s; att::unit(lds, QKV, CAT, a.in[I_SUBG], lam, bh >> 2, bh & 3, u); }
        }
        for (int u = vcu; u < 1024; u += G) gm::unit(lds, Zb, CAT, TRIL, a.in[I_GLNG], a.in[I_GLNB], a.in[I_BSP], u >> 8, (u >> 2) & 63, u & 3);
    }
    SEAM(2);
    if (IN(3)) {
        pg8::Gemm g{CAT, WoT, M, DM, DM}; pg8::StaticOrder S; S.init(M, DM, G, bx);
        EpiRes E{a.in[I_X], a.out};
        pg8::gemm_phase<EpiRes, pg8::StaticOrder, true, true>(lds, g, S, E);
    }
    SEAM(3);
    if (IN(4)) { for (int m = vcu * 8 + wave; m < M; m += G * 8) ln_row(a.out + (size_t)m * DM, a.out + (size_t)m * DM, X1B + (size_t)m * DM, a.in[I_LN1G], a.in[I_LN1B], lane); }
    SEAM(4);
    if (IN(5)) {
        pg8::Gemm g{X1B, WguT, M, NGU, DM}; pg8::StaticOrder S; S.init(M, NGU, G, bx);
        EpiGU E{Gb, Ub};
        pg8::gemm_phase<EpiGU, pg8::StaticOrder, true, true>(lds, g, S, E);
    }
    SEAM(5);
    if (IN(6)) {
        const float* cw = a.in[I_CONVW]; const float* cb = a.in[I_CONVB];
        for (int task = bx * 512 + tid; task < (M / 32) * (FF / 8); task += G * 512) {
            const int cgp = task % (FF / 8), rr = task / (FF / 8), f0 = 8 * cgp, r0 = 32 * rr;
            float w0[8], w1[8], w2[8], bb[8], gm2[8], gm1[8];
#pragma unroll
            for (int i = 0; i < 8; ++i) { w0[i] = cw[f0 + i]; w1[i] = cw[FF + f0 + i]; w2[i] = cw[2 * FF + f0 + i]; bb[i] = cb[f0 + i]; }
            if ((r0 & (SEQ - 1)) != 0) {
                const u32x4 a2 = *(const u32x4*)(Gb + (size_t)(r0 - 2) * FF + f0), a1 = *(const u32x4*)(Gb + (size_t)(r0 - 1) * FF + f0);
                gm2[0] = bflo(a2.x); gm2[1] = bfhi(a2.x); gm2[2] = bflo(a2.y); gm2[3] = bfhi(a2.y); gm2[4] = bflo(a2.z); gm2[5] = bfhi(a2.z); gm2[6] = bflo(a2.w); gm2[7] = bfhi(a2.w);
                gm1[0] = bflo(a1.x); gm1[1] = bfhi(a1.x); gm1[2] = bflo(a1.y); gm1[3] = bfhi(a1.y); gm1[4] = bflo(a1.z); gm1[5] = bfhi(a1.z); gm1[6] = bflo(a1.w); gm1[7] = bfhi(a1.w);
            } else {
#pragma unroll
                for (int i = 0; i < 8; ++i) { gm2[i] = 0.f; gm1[i] = 0.f; }
            }
#pragma unroll 4
            for (int r = 0; r < 32; ++r) {
                const size_t off = (size_t)(r0 + r) * FF + f0;
                const u32x4 gw = *(const u32x4*)(Gb + off), uw = *(const u32x4*)(Ub + off);
                float gc[8], uu[8], o[8];
                gc[0] = bflo(gw.x); gc[1] = bfhi(gw.x); gc[2] = bflo(gw.y); gc[3] = bfhi(gw.y); gc[4] = bflo(gw.z); gc[5] = bfhi(gw.z); gc[6] = bflo(gw.w); gc[7] = bfhi(gw.w);
                uu[0] = bflo(uw.x); uu[1] = bfhi(uw.x); uu[2] = bflo(uw.y); uu[3] = bfhi(uw.y); uu[4] = bflo(uw.z); uu[5] = bfhi(uw.z); uu[6] = bflo(uw.w); uu[7] = bfhi(uw.w);
#pragma unroll
                for (int i = 0; i < 8; ++i) {
                    const float y = bb[i] + w0[i] * gm2[i] + w1[i] * gm1[i] + w2[i] * gc[i];
                    const float sg = __builtin_amdgcn_rcpf(1.0f + __builtin_amdgcn_exp2f(-1.4426950408889634f * y));
                    o[i] = y * sg * uu[i]; gm2[i] = gm1[i]; gm1[i] = gc[i];
                }
                u32x4 w; w.x = cvt_pk_bf16(o[0], o[1]); w.y = cvt_pk_bf16(o[2], o[3]); w.z = cvt_pk_bf16(o[4], o[5]); w.w = cvt_pk_bf16(o[6], o[7]);
                *(u32x4*)(Ub + off) = w;
            }
        }
    }
    SEAM(6);
    if (IN(7)) {
        pg8::Gemm g{Ub, WdT, M, DM, FF}; pg8::StaticOrder S; S.init(M, DM, G, bx);
        EpiRes E{a.out, a.out};
        pg8::gemm_phase<EpiRes, pg8::StaticOrder, true, true>(lds, g, S, E);
    }
    SEAM(7);
    if (IN(8)) { for (int m = vcu * 8 + wave; m < M; m += G * 8) ln_row(a.out + (size_t)m * DM, a.out + (size_t)m * DM, nullptr, a.in[I_LN2G], a.in[I_LN2B], lane); }
#undef IN
#undef SEAM
}

extern "C" void kernel_launch(void* const* d_in, const int* in_sizes, int n_in, void* d_out, int out_size, void* d_ws, size_t ws_size, hipStream_t stream) {
    static int grid = 0;
    if (grid == 0) {
        if (n_in != 21 || in_sizes[0] != M * DM || out_size != M * DM || ws_size < WS_END) { fprintf(stderr, "kernel_launch: unexpected shapes (n_in %d, in0 %d, out %d, ws %zu)\n", n_in, n_in > 0 ? in_sizes[0] : -1, out_size, ws_size); grid = -1; return; }
        int dev = 0, cus = 0, per_cu = 0;
        hipGetDevice(&dev); hipDeviceGetAttribute(&cus, hipDeviceAttributeMultiprocessorCount, dev);
        hipFuncSetAttribute((const void*)fwd, hipFuncAttributeMaxDynamicSharedMemorySize, LDS_BYTES);
        if (hipOccupancyMaxActiveBlocksPerMultiprocessor(&per_cu, (const void*)fwd, 512, LDS_BYTES) != hipSuccess || per_cu < 1) per_cu = 1;
        (void)hipGetLastError();
        grid = cus * per_cu;
        if (grid <= 0) grid = 256;
    }
    if (grid < 0) return;
    Args a{};
    for (int i = 0; i < 21; ++i) a.in[i] = (const float*)d_in[i];
    a.out = (float*)d_out; a.ws = (unsigned char*)d_ws;
#if MK_N_LAUNCHES == 1
    a.ph_lo = 0; a.ph_hi = NPHASE;
    void* args[] = {&a};
    hipError_t e = hipLaunchCooperativeKernel((const void*)fwd, dim3(grid), dim3(512), args, LDS_BYTES, stream);
    if (e != hipSuccess) fprintf(stderr, "cooperative launch failed: %s (grid %d)\n", hipGetErrorString(e), grid);
#else
    for (int p = 0; p < NPHASE; ++p) { a.ph_lo = p; a.ph_hi = p + 1; hipLaunchKernelGGL(fwd, dim3(grid), dim3(512), LDS_BYTES, stream, a); }
#endif
}
```

```cpp
#include <hip/hip_runtime.h>
#include <hip/hip_cooperative_groups.h>
#include <cstdio>
#include <cstdint>
namespace cg = cooperative_groups;
namespace pg8 {
#define PG8_LAS __attribute__((address_space(3)))
typedef unsigned short bf16_t;
typedef short bf16x8 __attribute__((ext_vector_type(8)));
typedef float f32x4 __attribute__((ext_vector_type(4)));
typedef unsigned u32x4 __attribute__((ext_vector_type(4)));
constexpr int BM = 256, BK = 64, HALF = 128, HTB = HALF * BK * 2  , STAGE_BYTES = 8 * HTB, NXCD = 8, WGM = 8;

__host__ __device__ __forceinline__ int lds_byte(int r, int c) { const int st = (r >> 4) * 2 + (c >> 5), rr = r & 15, cc = c & 31, ob = rr * 64 + cc * 2; return st * 1024 + (ob ^ (((ob >> 9) & 1) << 5)); }
__host__ __device__ __forceinline__ void stage_rc(int b, int& R, int& C) { const int st = b / 1024, sb = b % 1024, swz = sb ^ (((sb >> 9) & 1) << 5); R = (st >> 1) * 16 + swz / 64; C = (st & 1) * 32 + (swz % 64) / 2; }
__host__ __device__ __forceinline__ int perm32(int rho) { const int n = rho >> 4, i = rho & 15; return 8 * (i >> 2) + 4 * n + (i & 3); }

struct Unit { int pm, pn; };
struct Gemm { const bf16_t* A; const bf16_t* Bt; int M, N, K; };

struct StaticOrder {
    int nM, nN, nwg, G, c;
    __host__ __device__ void init(int M, int N, int G_, int c_) { nM = M / BM; nN = N / BM; nwg = nM * nN; G = G_; c = c_; }
    __host__ __device__ bool next(int i, Unit& u) const {
        const long L = (long)i * G + c; if (L >= nwg) return false;
        int wgid = (int)L; { const int q = nwg / NXCD, r = nwg % NXCD, xcd = wgid % NXCD, off = wgid / NXCD; wgid = (xcd < r ? xcd * (q + 1) : r * (q + 1) + (xcd - r) * q) + off; }
        const int nig = WGM * nN, gid = wgid / nig, fm = gid * WGM, gsz = (nM - fm) < WGM ? (nM - fm) : WGM;
        u.pm = fm + ((wgid % nig) % gsz); u.pn = (wgid % nig) / gsz; return true;
    }
    __device__ __forceinline__ void a_ready(const Unit&) const {}
    __device__ __forceinline__ void done(const Unit&) const {}
};

__device__ __forceinline__ unsigned cvt_pk_bf16(float lo, float hi) { unsigned r; asm volatile("v_cvt_pk_bf16_f32 %0, %1, %2" : "=v"(r) : "v"(lo), "v"(hi)); return r; }
typedef float f32x2 __attribute__((ext_vector_type(2)));
__device__ __forceinline__ f32x2 gelu_pk(f32x2 v) {
    const f32x2 av = __builtin_elementwise_abs(v), d = av * 0.2316418882f + 1.0f;
    f32x2 t; t.x = __builtin_amdgcn_rcpf(d.x); t.y = __builtin_amdgcn_rcpf(d.y);
    f32x2 q = t * 0.5307027145f + (-0.7265760135f); q = q * t + 0.7107068705f; q = q * t + (-0.142248368f); q = q * t + 0.127414796f; q = q * t;
    const f32x2 s = (v * v) * (-0.72134752044f);
    f32x2 e; e.x = __builtin_amdgcn_exp2f(s.x); e.y = __builtin_amdgcn_exp2f(s.y);
    const f32x2 m = v * (q * e), r = v - m;
    f32x2 o; o.x = v.x < 0.f ? m.x : r.x; o.y = v.y < 0.f ? m.y : r.y; return o;
}
template <class Epi, class Sched, bool ALIGN_EPI = false, bool SP2 = false>
__device__ __forceinline__ void gemm_phase(PG8_LAS unsigned char* lds, const Gemm g, const Sched& S, const Epi& E) {
    const int tid = threadIdx.x, wid = __builtin_amdgcn_readfirstlane(tid >> 6), lane = tid & 63, wr = wid >> 2, wc = wid & 3, fr = lane & 15, fq = lane >> 4;
    const int K = g.K, nt = K / BK;
    unsigned voffA[2], voffB[2];
#pragma unroll
    for (int i = 0; i < 2; ++i) { int R, C; stage_rc(tid * 16 + i * 8192, R, C); const int Rb = Epi::PERM ? ((R & ~31) + perm32(R & 31)) : R;
        voffA[i] = (unsigned)(R * K + C) * 2u; voffB[i] = (unsigned)(Rb * K + C) * 2u; }
    const size_t kstep = (size_t)(BK * 2);
    const size_t hstep = (size_t)HALF * K * 2;
    const size_t tstep = 2 * hstep;
    const unsigned ldsw = (unsigned)wid * 1024u;
    const int aoff = lds_byte(wr * 64 + fr, fq * 8), boff = lds_byte(wc * 32 + fr, fq * 8);
#define PG8_SA(b, h) (((b) * 2 + (h)) * HTB)
#define PG8_SB(b, h) ((4 + (b) * 2 + (h)) * HTB)
#define PG8_STAGE(bufoff, gbase, voff) do { _Pragma("unroll") for (int _i = 0; _i < 2; ++_i) \
        __builtin_amdgcn_global_load_lds((const unsigned*)((const char*)(gbase) + (voff)[_i]), (PG8_LAS unsigned*)(lds + (bufoff) + ldsw + _i * 8192), 16, 0, 0); } while (0)
#define PG8_LDA(dst, b, h) do { _Pragma("unroll") for (int m = 0; m < 4; ++m) _Pragma("unroll") for (int k = 0; k < 2; ++k) dst[m][k] = *(const PG8_LAS bf16x8*)(lds + PG8_SA(b, h) + aoff + m * 2048 + k * 1024); } while (0)
#define PG8_LDB(dst, b, h) do { _Pragma("unroll") for (int n = 0; n < 2; ++n) _Pragma("unroll") for (int k = 0; k < 2; ++k) dst[n][k] = *(const PG8_LAS bf16x8*)(lds + PG8_SB(b, h) + boff + n * 2048 + k * 1024); } while (0)
#define PG8_MMA(ai, bj, At, Bt) do { __builtin_amdgcn_s_setprio(1); _Pragma("unroll") for (int m = 0; m < 4; ++m) _Pragma("unroll") for (int n = 0; n < 2; ++n) _Pragma("unroll") for (int k = 0; k < 2; ++k) \
        acc[ai][bj][m][n] = __builtin_amdgcn_mfma_f32_16x16x32_bf16(Bt[n][k], At[m][k], acc[ai][bj][m][n], 0, 0, 0); __builtin_amdgcn_s_setprio(0); } while (0)
#define PG8_WAIT_V(n) asm volatile("s_waitcnt vmcnt(" #n ")" ::: "memory")
#define PG8_WAIT_L(n) asm volatile("s_waitcnt lgkmcnt(" #n ")" ::: "memory")
#define PG8_BAR __builtin_amdgcn_s_barrier()
#define PG8_SCHED __builtin_amdgcn_sched_barrier(0)
    Unit cur, nxt; int ui = 0;
    if (!S.next(0, cur)) return;
    f32x4 acc[2][2][4][2];
#pragma unroll
    for (int a = 0; a < 2; ++a)
#pragma unroll
        for (int b = 0; b < 2; ++b)
#pragma unroll
            for (int m = 0; m < 4; ++m)
#pragma unroll
                for (int n = 0; n < 2; ++n) acc[a][b][m][n] = (f32x4){0.f, 0.f, 0.f, 0.f};
    bf16x8 At[4][2], B0[2][2], B1[2][2];
    const char* cA = (const char*)g.A + (size_t)cur.pm * tstep; const char* cB = (const char*)g.Bt + (size_t)cur.pn * tstep;
    S.a_ready(cur);
    if constexpr (SP2) {
        PG8_STAGE(PG8_SB(0, 0), cB, voffB); PG8_STAGE(PG8_SB(0, 1), cB + hstep, voffB); PG8_STAGE(PG8_SA(0, 0), cA, voffA); PG8_STAGE(PG8_SA(0, 1), cA + hstep, voffA);
        if (wr == 1) PG8_BAR;
        PG8_WAIT_V(2); PG8_BAR;
        PG8_STAGE(PG8_SB(1, 0), cB + kstep, voffB); PG8_STAGE(PG8_SA(1, 0), cA + kstep, voffA); PG8_STAGE(PG8_SB(1, 1), cB + hstep + kstep, voffB);
        PG8_WAIT_V(6); PG8_BAR;
    } else {
        PG8_STAGE(PG8_SB(0, 0), cB, voffB); PG8_STAGE(PG8_SA(0, 0), cA, voffA); PG8_STAGE(PG8_SB(0, 1), cB + hstep, voffB); PG8_STAGE(PG8_SA(0, 1), cA + hstep, voffA);
        if (wr == 1) PG8_BAR;
        PG8_WAIT_V(4); PG8_BAR;
        PG8_STAGE(PG8_SB(1, 0), cB + kstep, voffB); PG8_STAGE(PG8_SA(1, 0), cA + kstep, voffA); PG8_STAGE(PG8_SB(1, 1), cB + hstep + kstep, voffB);
        PG8_WAIT_V(6); PG8_BAR;
    }
    for (;;) {
        const bool has_next = S.next(ui + 1, nxt);
        const char* nA = has_next ? (const char*)g.A + (size_t)nxt.pm * tstep : cA; const char* nB = has_next ? (const char*)g.Bt + (size_t)nxt.pn * tstep : cB;
        for (int t = 0; t < nt; t += 2) {
            const bool last = (t == nt - 2);
            const char* a1 = cA + (size_t)(t + 1) * kstep;
            const char* a2 = last ? nA : cA + (size_t)(t + 2) * kstep; const char* b2 = last ? nB : cB + (size_t)(t + 2) * kstep;
            const char* a3 = a2 + kstep; const char* b3 = b2 + kstep;
            if (last && has_next) S.a_ready(nxt);
            if constexpr (SP2) {
            PG8_LDB(B0, 0, 0); PG8_LDB(B1, 0, 1); PG8_SCHED; PG8_LDA(At, 0, 0); PG8_STAGE(PG8_SA(1, 1), a1 + hstep, voffA);
            PG8_WAIT_V(8); PG8_WAIT_L(0); PG8_BAR; PG8_MMA(0, 0, At, B0); PG8_MMA(0, 1, At, B1); PG8_BAR; PG8_SCHED;
            PG8_LDA(At, 0, 1); PG8_STAGE(PG8_SB(0, 0), b2, voffB); PG8_STAGE(PG8_SB(0, 1), b2 + hstep, voffB); PG8_STAGE(PG8_SA(0, 0), a2, voffA);
            PG8_WAIT_V(8); PG8_WAIT_L(0); PG8_BAR; PG8_MMA(1, 0, At, B0); PG8_MMA(1, 1, At, B1); PG8_BAR; PG8_SCHED;
            PG8_LDB(B0, 1, 0); PG8_LDB(B1, 1, 1); PG8_SCHED; PG8_LDA(At, 1, 0); PG8_STAGE(PG8_SA(0, 1), a2 + hstep, voffA);
            PG8_WAIT_V(8); PG8_WAIT_L(0); PG8_BAR; PG8_MMA(0, 0, At, B0); PG8_MMA(0, 1, At, B1); PG8_BAR; PG8_SCHED;
            PG8_LDA(At, 1, 1); PG8_STAGE(PG8_SB(1, 0), b3, voffB); PG8_STAGE(PG8_SB(1, 1), b3 + hstep, voffB); PG8_STAGE(PG8_SA(1, 0), a3, voffA);
            PG8_WAIT_V(8); PG8_WAIT_L(0); PG8_BAR; PG8_MMA(1, 0, At, B0); PG8_MMA(1, 1, At, B1); PG8_BAR; PG8_SCHED;
            } else {
            PG8_LDB(B0, 0, 0); PG8_SCHED; PG8_LDA(At, 0, 0); PG8_STAGE(PG8_SA(1, 1), a1 + hstep, voffA);
            PG8_WAIT_L(8); PG8_BAR; PG8_WAIT_L(0); PG8_MMA(0, 0, At, B0); PG8_BAR; PG8_SCHED;
            PG8_LDB(B1, 0, 1); PG8_STAGE(PG8_SB(0, 0), b2, voffB);
            PG8_BAR; PG8_WAIT_L(0); PG8_MMA(0, 1, At, B1); PG8_BAR;
            PG8_LDA(At, 0, 1); PG8_STAGE(PG8_SA(0, 0), a2, voffA);
            PG8_BAR; PG8_WAIT_L(0); PG8_MMA(1, 0, At, B0); PG8_BAR; PG8_SCHED;
            PG8_STAGE(PG8_SB(0, 1), b2 + hstep, voffB);
            PG8_WAIT_V(6); PG8_BAR; PG8_MMA(1, 1, At, B1); PG8_BAR;
            PG8_LDB(B0, 1, 0); PG8_SCHED; PG8_LDA(At, 1, 0); PG8_STAGE(PG8_SA(0, 1), a2 + hstep, voffA);
            PG8_WAIT_L(8); PG8_BAR; PG8_WAIT_L(0); PG8_MMA(0, 0, At, B0); PG8_BAR; PG8_SCHED;
            PG8_LDB(B1, 1, 1); PG8_STAGE(PG8_SB(1, 0), b3, voffB);
            PG8_BAR; PG8_WAIT_L(0); PG8_MMA(0, 1, At, B1); PG8_BAR;
            PG8_LDA(At, 1, 1); PG8_STAGE(PG8_SA(1, 0), a3, voffA);
            PG8_BAR; PG8_WAIT_L(0); PG8_MMA(1, 0, At, B0); PG8_BAR; PG8_SCHED;
            PG8_STAGE(PG8_SB(1, 1), b3 + hstep, voffB);
            PG8_WAIT_V(6); PG8_BAR; PG8_MMA(1, 1, At, B1); PG8_BAR;
            }
        }
        if constexpr (ALIGN_EPI) { if (wr == 0) PG8_BAR; }
        if constexpr (!Epi::AFTER_DRAIN) { E(acc, cur, wr, wc, fr, fq); S.done(cur); }
        if (!has_next) break;
#pragma unroll
        for (int a = 0; a < 2; ++a)
#pragma unroll
            for (int b = 0; b < 2; ++b)
#pragma unroll
                for (int m = 0; m < 4; ++m)
#pragma unroll
                    for (int n = 0; n < 2; ++n) acc[a][b][m][n] = (f32x4){0.f, 0.f, 0.f, 0.f};
        cur = nxt; cA = nA; cB = nB; ++ui;
        if constexpr (ALIGN_EPI) { if (wr == 1) PG8_BAR; }
    }
    PG8_WAIT_V(0);
    if constexpr (!ALIGN_EPI) { if (wr == 0) PG8_BAR; }
    PG8_BAR;
    if constexpr (Epi::AFTER_DRAIN) { E.fused(acc, cur, wr, wc, fr, fq, lds, wid, lane); S.done(cur); }
#undef PG8_SA
#undef PG8_SB
#undef PG8_STAGE
#undef PG8_LDA
#undef PG8_LDB
#undef PG8_MMA
#undef PG8_WAIT_V
#undef PG8_WAIT_L
#undef PG8_BAR
#undef PG8_SCHED
}
}

#ifndef MK_N_LAUNCHES
#define MK_N_LAUNCHES 1
#endif
constexpr int BATCH = 4, SEQ = 8192, DM = 1024, M = BATCH * SEQ, NIN = 2560, FF = 2816, NGU = 2 * FF, QKVP = 1536;
constexpr float LN_EPS = 1e-5f;
constexpr float ALPHA = 1.189207115002721f;
constexpr float C2 = 0.125f * 1.4426950408889634f;
constexpr int NPHASE = 9;
constexpr size_t MiB = 1u << 20;
constexpr size_t WS_WIN = 1 * MiB, WS_WO = 6 * MiB, WS_WGU = 8 * MiB, WS_WD = 19 * MiB, WS_ROPE = 25 * MiB, WS_TRIL = 27 * MiB, WS_X1B = 28 * MiB;
constexpr size_t WS_BIG = 92 * MiB;
constexpr size_t WS_XB = WS_BIG, WS_QKV = WS_BIG + 64 * MiB, WS_Z = WS_BIG + 160 * MiB, WS_CAT = WS_BIG + 224 * MiB;
constexpr size_t WS_G = WS_BIG, WS_U = WS_BIG + 176 * MiB, WS_END = WS_BIG + 352 * MiB;
constexpr int LDS_BYTES = 147456;

#define LAS __attribute__((address_space(3)))
typedef unsigned short bf16_t;
typedef short bf16x8 __attribute__((ext_vector_type(8)));
typedef short s16x4 __attribute__((ext_vector_type(4)));
typedef float f32x4 __attribute__((ext_vector_type(4)));
typedef float f32x2 __attribute__((ext_vector_type(2)));
typedef unsigned u32x4 __attribute__((ext_vector_type(4)));
typedef unsigned u32x2 __attribute__((ext_vector_type(2)));
using pg8::cvt_pk_bf16;
using pg8::Unit;

__device__ __forceinline__ float wave_sum(float v) {
#pragma unroll
    for (int o = 1; o < 64; o <<= 1) v += __shfl_xor(v, o);
    return v;
}
__device__ __forceinline__ float bf2f(unsigned short h) { return __uint_as_float((unsigned)h << 16); }
__device__ __forceinline__ float bflo(unsigned w) { return __uint_as_float(w << 16); }
__device__ __forceinline__ float bfhi(unsigned w) { return __uint_as_float(w & 0xffff0000u); }

struct EpiIn {
    static constexpr bool PERM = true, AFTER_DRAIN = false;
    bf16_t* QKV; bf16_t* Z; const float* rope;
    __device__ __forceinline__ void operator()(const f32x4 (&acc)[2][2][4][2], const Unit& u, int wr, int wc, int fr, int fq) const {
        const int row0 = u.pm * 256 + wr * 64 + fr, colt = u.pn * 256;
#pragma unroll
        for (int ai = 0; ai < 2; ++ai)
#pragma unroll
            for (int m = 0; m < 4; ++m) {
                const int row = row0 + ai * 128 + m * 16;
#pragma unroll
                for (int bj = 0; bj < 2; ++bj) {
                    const int c0 = colt + bj * 128 + wc * 32 + 8 * fq;
                    f32x4 v0 = acc[ai][bj][m][0], v1 = acc[ai][bj][m][1];
                    if (colt < 1024) {
                        const int d = (c0 & 63) >> 1, pos = row & (SEQ - 1);
                        const f32x4 cs = *(const f32x4*)(rope + pos * 64 + d), sn = *(const f32x4*)(rope + pos * 64 + 32 + d);
                        f32x4 lo = v0 * cs - v1 * sn, hi = v1 * cs + v0 * sn;
                        if (colt < 512) { lo = lo * C2; hi = hi * C2; }
                        bf16_t* p = QKV + (size_t)row * QKVP + (c0 & ~63) + d;
                        u32x2 a, b; a.x = cvt_pk_bf16(lo[0], lo[1]); a.y = cvt_pk_bf16(lo[2], lo[3]); b.x = cvt_pk_bf16(hi[0], hi[1]); b.y = cvt_pk_bf16(hi[2], hi[3]);
                        *(u32x2*)p = a; *(u32x2*)(p + 32) = b;
                    } else if (colt < 1536) {
                        u32x4 w; w.x = cvt_pk_bf16(v0[0], v0[1]); w.y = cvt_pk_bf16(v0[2], v0[3]); w.z = cvt_pk_bf16(v1[0], v1[1]); w.w = cvt_pk_bf16(v1[2], v1[3]);
                        *(u32x4*)(QKV + (size_t)row * QKVP + c0) = w;
                    } else {
                        const pg8::f32x2 a = pg8::gelu_pk((pg8::f32x2){v0[0], v0[1]}), b = pg8::gelu_pk((pg8::f32x2){v0[2], v0[3]}), c = pg8::gelu_pk((pg8::f32x2){v1[0], v1[1]}), e = pg8::gelu_pk((pg8::f32x2){v1[2], v1[3]});
                        u32x4 w; w.x = cvt_pk_bf16(a.x, a.y); w.y = cvt_pk_bf16(b.x, b.y); w.z = cvt_pk_bf16(c.x, c.y); w.w = cvt_pk_bf16(e.x, e.y);
                        *(u32x4*)(Z + (size_t)row * 1024 + (c0 - 1536)) = w;
                    }
                }
            }
    }
};
struct EpiRes {
    static constexpr bool PERM = false, AFTER_DRAIN = false;
    const float* base; float* out;
    __device__ __forceinline__ void operator()(const f32x4 (&acc)[2][2][4][2], const Unit& u, int wr, int wc, int fr, int fq) const {
        const int row0 = u.pm * 256 + wr * 64 + fr, col0 = u.pn * 256 + wc * 32 + 4 * fq;
#pragma unroll
        for (int ai = 0; ai < 2; ++ai)
#pragma unroll
            for (int m = 0; m < 4; ++m) {
                const size_t off = (size_t)(row0 + ai * 128 + m * 16) * DM + col0;
#pragma unroll
                for (int bj = 0; bj < 2; ++bj)
#pragma unroll
                    for (int n = 0; n < 2; ++n) { const f32x4 bs = *(const f32x4*)(base + off + bj * 128 + n * 16); *(f32x4*)(out + off + bj * 128 + n * 16) = bs * ALPHA + acc[ai][bj][m][n]; }
            }
    }
};
struct EpiGU {
    static constexpr bool PERM = true, AFTER_DRAIN = false;
    bf16_t* G; bf16_t* U;
    __device__ __forceinline__ void operator()(const f32x4 (&acc)[2][2][4][2], const Unit& u, int wr, int wc, int fr, int fq) const {
        const int row0 = u.pm * 256 + wr * 64 + fr, f0 = u.pn * 128 + wc * 32 + 8 * fq;
#pragma unroll
        for (int ai = 0; ai < 2; ++ai)
#pragma unroll
            for (int m = 0; m < 4; ++m) {
                const size_t off = (size_t)(row0 + ai * 128 + m * 16) * FF + f0;
#pragma unroll
                for (int bj = 0; bj < 2; ++bj) {
                    const f32x4 v0 = acc[ai][bj][m][0], v1 = acc[ai][bj][m][1];
                    u32x4 w; w.x = cvt_pk_bf16(v0[0], v0[1]); w.y = cvt_pk_bf16(v0[2], v0[3]); w.z = cvt_pk_bf16(v1[0], v1[1]); w.w = cvt_pk_bf16(v1[2], v1[3]);
                    *(u32x4*)((bj ? U : G) + off) = w;
                }
            }
    }
};

__device__ __forceinline__ unsigned f2bf(float f) { unsigned u = __builtin_bit_cast(unsigned, f); return (u + 0x7fffu + ((u >> 16) & 1u)) >> 16; }
__device__ __forceinline__ unsigned pk2(float lo, float hi) { return f2bf(lo) | (f2bf(hi) << 16); }
template <int MODE> __device__ __forceinline__ const float* wsrc(const float* W, const float* W2, int j, int& N) {
    if (MODE == 1) { if (j < 1024) { const int jj = j & 63; j = (j - jj) + 32 * ((jj >> 2) & 1) + 4 * (jj >> 3) + (jj & 3); } return W + j; }
    if (MODE == 2) { const int pn = j >> 8, bj = (j >> 7) & 1, f = (pn << 7) + (j & 127); return (bj ? W2 : W) + f; }
    return W + j;
}
template <int MODE> __device__ __forceinline__ void transpose_item(const float* W, const float* W2, int K, int N, int NOUT, bf16_t* WT, LAS float* scr, int item, int lane) {
    const int nblk = NOUT / 32, kb = item / nblk, nb = item % nblk, k0 = 64 * kb, n0 = 32 * nb;
    int Nn = N; const float* src = wsrc<MODE>(W, W2, n0 + (lane & 31), Nn);
#pragma unroll 8
    for (int i = 0; i < 32; ++i) { const int kk = 2 * i + (lane >> 5); scr[kk * 33 + (lane & 31)] = src[(size_t)(k0 + kk) * N]; }
    asm volatile("s_waitcnt lgkmcnt(0)" ::: "memory");
    const int c = lane & 7;
#pragma unroll
    for (int j = 0; j < 4; ++j) { const int n = (lane >> 3) + 8 * j; const LAS float* s = scr + (8 * c) * 33 + n;
        u32x4 o; o.x = pk2(s[0 * 33], s[1 * 33]); o.y = pk2(s[2 * 33], s[3 * 33]); o.z = pk2(s[4 * 33], s[5 * 33]); o.w = pk2(s[6 * 33], s[7 * 33]);
        *(u32x4*)(WT + (size_t)(n0 + n) * K + k0 + 8 * c) = o; }
    asm volatile("s_waitcnt lgkmcnt(0)" ::: "memory");
}
__device__ __forceinline__ void ln_row(const float* in, float* outf, bf16_t* outb, const float* g, const float* b, int lane) {
    const f32x4* xr = (const f32x4*)in + lane;
    f32x4 v[4]; float s = 0.f;
#pragma unroll
    for (int j = 0; j < 4; ++j) { v[j] = xr[64 * j]; s += (v[j].x + v[j].y) + (v[j].z + v[j].w); }
    const float mean = wave_sum(s) * (1.f / DM); float s2 = 0.f;
#pragma unroll
    for (int j = 0; j < 4; ++j) { v[j] = v[j] - mean; s2 += (v[j].x * v[j].x + v[j].y * v[j].y) + (v[j].z * v[j].z + v[j].w * v[j].w); }
    const float rstd = 1.f / sqrtf(wave_sum(s2) * (1.f / DM) + LN_EPS);
#pragma unroll
    for (int j = 0; j < 4; ++j) {
        const f32x4 gv = ((const f32x4*)g)[lane + 64 * j], bv = ((const f32x4*)b)[lane + 64 * j];
        const f32x4 y = v[j] * rstd * gv + bv;
        if (outf) ((f32x4*)outf)[lane + 64 * j] = y;
        if (outb) { u32x2 w; w.x = cvt_pk_bf16(y.x, y.y); w.y = cvt_pk_bf16(y.z, y.w); ((u32x2*)outb)[lane + 64 * j] = w; }
    }
}

namespace att {
constexpr int KB = 8192, VSTR = 288, VB = 64 * VSTR, BUF = 2 * KB + VB;
__device__ __forceinline__ s16x4 vtr(const LAS unsigned char* p) { return __builtin_bit_cast(s16x4, __builtin_amdgcn_ds_read_tr16_b64_v4i16((LAS s16x4*)p)); }

__device__ __forceinline__ void softmax_tile(f32x4 (&s)[4], float& m, float& l, f32x4 (&O)[8], bf16x8 (&P)[2]) {
    float mx = fmaxf(fmaxf(s[0][0], s[0][1]), fmaxf(s[0][2], s[0][3]));
#pragma unroll
    for (int T = 1; T < 4; ++T) mx = fmaxf(mx, fmaxf(fmaxf(s[T][0], s[T][1]), fmaxf(s[T][2], s[T][3])));
    mx = fmaxf(mx, __shfl_xor(mx, 16)); mx = fmaxf(mx, __shfl_xor(mx, 32));
    const float mn = fmaxf(m, mx);
    if (__any(mn > m)) {
        const float a = __builtin_amdgcn_exp2f(m - mn); l *= a;
#pragma unroll
        for (int t = 0; t < 8; ++t) O[t] = O[t] * a;
        m = mn;
    }
    float sum = 0.f; unsigned w[8];
#pragma unroll
    for (int T = 0; T < 4; ++T) {
        const float p0 = __builtin_amdgcn_exp2f(s[T][0] - m), p1 = __builtin_amdgcn_exp2f(s[T][1] - m), p2 = __builtin_amdgcn_exp2f(s[T][2] - m), p3 = __builtin_amdgcn_exp2f(s[T][3] - m);
        sum += (p0 + p1) + (p2 + p3); w[2 * T] = cvt_pk_bf16(p0, p1); w[2 * T + 1] = cvt_pk_bf16(p2, p3);
    }
    l += sum;
    P[0] = __builtin_bit_cast(bf16x8, (u32x4){w[0], w[1], w[2], w[3]});
    P[1] = __builtin_bit_cast(bf16x8, (u32x4){w[4], w[5], w[6], w[7]});
}

__device__ __forceinline__ void unit(LAS unsigned char* lds, const bf16_t* QKV, bf16_t* CAT, const float* subg, float lam, int b, int h, int u) {
    const int tid = threadIdx.x, lane = tid & 63, wid = __builtin_amdgcn_readfirstlane(tid >> 6), l15 = lane & 15, quad = lane >> 4;
    const size_t rowbase = (size_t)b * SEQ;
    const int q0 = 128 * u + 16 * wid, mychunk = q0 >> 6, NT = 2 * u + 2;
    const bf16_t* qp = QKV + (rowbase + q0 + l15) * QKVP + (2 * h) * 64 + 8 * quad;
    bf16x8 q1[2], q2[2];
    q1[0] = *(const bf16x8*)(qp); q1[1] = *(const bf16x8*)(qp + 32); q2[0] = *(const bf16x8*)(qp + 64); q2[1] = *(const bf16x8*)(qp + 96);
    const int skey = tid >> 3, spart = tid & 7, vkey = tid >> 4, vpart = tid & 15;
    const bf16_t* kg = QKV + (rowbase + skey) * QKVP + 512 + (2 * h) * 64 + spart * 8;
    const bf16_t* vg = QKV + (rowbase + vkey) * QKVP + 1024 + h * 128 + vpart * 8;
    const unsigned kl = skey * 128 + 16 * (spart ^ (skey & 7)), vl = 2 * KB + vkey * VSTR + vpart * 16;
    u32x4 rk1, rk2, rv0, rv1;
#define ATT_GLOAD(j) do { const size_t o_ = (size_t)(j) * 64 * QKVP; rk1 = *(const u32x4*)(kg + o_); rk2 = *(const u32x4*)(kg + o_ + 64); rv0 = *(const u32x4*)(vg + o_); rv1 = *(const u32x4*)(vg + o_ + 32 * QKVP); } while (0)
#define ATT_LSTORE(bufi) do { LAS unsigned char* B_ = lds + (bufi) * BUF; *(LAS u32x4*)(B_ + kl) = rk1; *(LAS u32x4*)(B_ + KB + kl) = rk2; *(LAS u32x4*)(B_ + vl) = rv0; *(LAS u32x4*)(B_ + vl + 32 * VSTR) = rv1; } while (0)
    f32x4 O1[8], O2[8];
#pragma unroll
    for (int t = 0; t < 8; ++t) { O1[t] = (f32x4){0.f, 0.f, 0.f, 0.f}; O2[t] = (f32x4){0.f, 0.f, 0.f, 0.f}; }
    float m1 = -INFINITY, m2 = -INFINITY, l1 = 0.f, l2 = 0.f;
    const unsigned koff0 = l15 * 128 + 16 * (quad ^ (l15 & 7)), koff1 = l15 * 128 + 16 * ((4 + quad) ^ (l15 & 7));
    const unsigned voff = 2 * KB + (4 * quad + (l15 >> 2)) * VSTR + (l15 & 3) * 8;
    ATT_GLOAD(0); ATT_LSTORE(0); __syncthreads();
    for (int j = 0; j < NT; ++j) {
        if (j + 1 < NT) ATT_GLOAD(j + 1);
        if (j <= mychunk) {
            const LAS unsigned char* B = lds + (j & 1) * BUF;
            f32x4 s1[4], s2[4];
#pragma unroll
            for (int T = 0; T < 4; ++T) {
                const bf16x8 a0 = *(const LAS bf16x8*)(B + T * 2048 + koff0), a1 = *(const LAS bf16x8*)(B + T * 2048 + koff1);
                const bf16x8 c0 = *(const LAS bf16x8*)(B + KB + T * 2048 + koff0), c1 = *(const LAS bf16x8*)(B + KB + T * 2048 + koff1);
                f32x4 z = (f32x4){0.f, 0.f, 0.f, 0.f};
                s1[T] = __builtin_amdgcn_mfma_f32_16x16x32_bf16(a0, q1[0], z, 0, 0, 0); s1[T] = __builtin_amdgcn_mfma_f32_16x16x32_bf16(a1, q1[1], s1[T], 0, 0, 0);
                s2[T] = __builtin_amdgcn_mfma_f32_16x16x32_bf16(c0, q2[0], z, 0, 0, 0); s2[T] = __builtin_amdgcn_mfma_f32_16x16x32_bf16(c1, q2[1], s2[T], 0, 0, 0);
            }
            bf16x8 P1[2], P2[2];
            softmax_tile(s1, m1, l1, O1, P1);
            softmax_tile(s2, m2, l2, O2, P2);
#pragma unroll
            for (int Td = 0; Td < 8; ++Td)
#pragma unroll
                for (int ks = 0; ks < 2; ++ks) {
                    const s16x4 lo = vtr(B + voff + (32 * ks) * VSTR + 32 * Td), hi = vtr(B + voff + (32 * ks + 16) * VSTR + 32 * Td);
                    const bf16x8 vf = (bf16x8){lo[0], lo[1], lo[2], lo[3], hi[0], hi[1], hi[2], hi[3]};
                    O1[Td] = __builtin_amdgcn_mfma_f32_16x16x32_bf16(vf, P1[ks], O1[Td], 0, 0, 0);
                    O2[Td] = __builtin_amdgcn_mfma_f32_16x16x32_bf16(vf, P2[ks], O2[Td], 0, 0, 0);
                }
        }
        if (j + 1 < NT) ATT_LSTORE((j + 1) & 1);
        __syncthreads();
    }
#undef ATT_GLOAD
#undef ATT_LSTORE
    l1 += __shfl_xor(l1, 16); l1 += __shfl_xor(l1, 32); l2 += __shfl_xor(l2, 16); l2 += __shfl_xor(l2, 32);
    const float r1 = 1.f / l1, r2 = lam / l2; float ss = 0.f;
#pragma unroll
    for (int t = 0; t < 8; ++t) { O1[t] = O1[t] * r1 - O2[t] * r2; ss += (O1[t][0] * O1[t][0] + O1[t][1] * O1[t][1]) + (O1[t][2] * O1[t][2] + O1[t][3] * O1[t][3]); }
    ss += __shfl_xor(ss, 16); ss += __shfl_xor(ss, 32);
    const float rn = 0.8f / sqrtf(ss * (1.f / 128.f) + LN_EPS);
    bf16_t* op = CAT + (rowbase + q0 + l15) * DM + h * 128 + 4 * quad;
#pragma unroll
    for (int t = 0; t < 8; ++t) { const f32x4 gv = *(const f32x4*)(subg + 16 * t + 4 * quad); const f32x4 y = O1[t] * rn * gv;
        u32x2 w; w.x = cvt_pk_bf16(y[0], y[1]); w.y = cvt_pk_bf16(y[2], y[3]); *(u32x2*)(op + 16 * t) = w; }
}
}

namespace gm {
constexpr int VSTR = 288;
__device__ __forceinline__ void unit(LAS unsigned char* lds, const bf16_t* Z, bf16_t* CAT, const bf16_t* TRIL, const float* lng, const float* lnb, const float* bs, int b, int c, int g) {
    const int tid = threadIdx.x, lane = tid & 63, wid = __builtin_amdgcn_readfirstlane(tid >> 6), l15 = lane & 15, quad = lane >> 4;
    const size_t row0 = (size_t)b * SEQ + 128 * c;
    {
        const int s = tid >> 2, seg = tid & 3;
        const bf16_t* zp = Z + (row0 + s) * 1024 + 512 + 128 * g + 32 * seg;
        float v[32];
#pragma unroll
        for (int i = 0; i < 4; ++i) { const u32x4 w = *(const u32x4*)(zp + 8 * i);
            v[8 * i + 0] = bflo(w.x); v[8 * i + 1] = bfhi(w.x); v[8 * i + 2] = bflo(w.y); v[8 * i + 3] = bfhi(w.y); v[8 * i + 4] = bflo(w.z); v[8 * i + 5] = bfhi(w.z); v[8 * i + 6] = bflo(w.w); v[8 * i + 7] = bfhi(w.w); }
        float sm = 0.f;
#pragma unroll
        for (int i = 0; i < 32; ++i) sm += v[i];
        sm += __shfl_xor(sm, 1); sm += __shfl_xor(sm, 2);
        const float mean = sm * (1.f / 128.f); float q = 0.f;
#pragma unroll
        for (int i = 0; i < 32; ++i) { v[i] -= mean; q += v[i] * v[i]; }
        q += __shfl_xor(q, 1); q += __shfl_xor(q, 2);
        const float rstd = 1.f / sqrtf(q * (1.f / 128.f) + LN_EPS);
        const float* gp = lng + 128 * g + 32 * seg; const float* bp = lnb + 128 * g + 32 * seg;
#pragma unroll
        for (int i = 0; i < 4; ++i) {
            const f32x4 g0 = *(const f32x4*)(gp + 8 * i), g1 = *(const f32x4*)(gp + 8 * i + 4), b0 = *(const f32x4*)(bp + 8 * i), b1 = *(const f32x4*)(bp + 8 * i + 4);
            u32x4 w;
            w.x = cvt_pk_bf16(v[8 * i + 0] * rstd * g0[0] + b0[0], v[8 * i + 1] * rstd * g0[1] + b0[1]);
            w.y = cvt_pk_bf16(v[8 * i + 2] * rstd * g0[2] + b0[2], v[8 * i + 3] * rstd * g0[3] + b0[3]);
            w.z = cvt_pk_bf16(v[8 * i + 4] * rstd * g1[0] + b1[0], v[8 * i + 5] * rstd * g1[1] + b1[1]);
            w.w = cvt_pk_bf16(v[8 * i + 6] * rstd * g1[2] + b1[2], v[8 * i + 7] * rstd * g1[3] + b1[3]);
            *(LAS u32x4*)(lds + s * VSTR + (32 * seg + 8 * i) * 2) = w;
        }
    }
    __syncthreads();
    const int t = 16 * wid + l15;
    f32x4 acc[8];
#pragma unroll
    for (int i = 0; i < 8; ++i) acc[i] = (f32x4){0.f, 0.f, 0.f, 0.f};
    const bf16_t* wp = TRIL + ((size_t)(g * 128 + t)) * 128 + 8 * quad;
    const unsigned voff = (8 * quad + (l15 >> 2)) * VSTR + (l15 & 3) * 8;
#pragma unroll
    for (int ks = 0; ks < 4; ++ks) {
        if (32 * ks <= 16 * wid + 15) {
            const bf16x8 wf = *(const bf16x8*)(wp + 32 * ks);
#pragma unroll
            for (int Td = 0; Td < 8; ++Td) {
                const s16x4 lo = att::vtr(lds + voff + (32 * ks) * VSTR + 32 * Td), hi = att::vtr(lds + voff + (32 * ks + 4) * VSTR + 32 * Td);
                const bf16x8 vf = (bf16x8){lo[0], lo[1], lo[2], lo[3], hi[0], hi[1], hi[2], hi[3]};
                acc[Td] = __builtin_amdgcn_mfma_f32_16x16x32_bf16(vf, wf, acc[Td], 0, 0, 0);
            }
        }
    }
    const float bt = bs[g * 128 + t];
    const bf16_t* up = Z + (row0 + t) * 1024 + 128 * g + 4 * quad;
    bf16_t* op = CAT + (row0 + t) * DM + 512 + 128 * g + 4 * quad;
#pragma unroll
    for (int Td = 0; Td < 8; ++Td) {
        const u32x2 uw = *(const u32x2*)(up + 16 * Td);
        u32x2 w; w.x = cvt_pk_bf16(bflo(uw.x) * (acc[Td][0] + bt), bfhi(uw.x) * (acc[Td][1] + bt)); w.y = cvt_pk_bf16(bflo(uw.y) * (acc[Td][2] + bt), bfhi(uw.y) * (acc[Td][3] + bt));
        *(u32x2*)(op + 16 * Td) = w;
    }
    __syncthreads();
}
}

#define RLX_AGENT __ATOMIC_RELAXED, __HIP_MEMORY_SCOPE_AGENT
#define XB_TMO      128
#define XB_XCNT(j)  (256  + 64 * (j))
#define XB_XSUB(j)  (1280 + 64 * (j))
#define XB_XGEN(j)  (2304 + 64 * (j))
#define XB_TOP      3328
#define XB_TOPGEN   3392
#define XCD_BAR_WORDS 3456
#define XB_SPIN_CAP (1u << 18)

__device__ __forceinline__ unsigned xb_ld(unsigned* p)              { return __hip_atomic_load(p, __ATOMIC_RELAXED, __HIP_MEMORY_SCOPE_AGENT); }
__device__ __forceinline__ unsigned xb_add(unsigned* p, unsigned v) { return __hip_atomic_fetch_add(p, v, __ATOMIC_RELAXED, __HIP_MEMORY_SCOPE_AGENT); }
__device__ __forceinline__ unsigned xb_xcc_id() { return (unsigned)__builtin_amdgcn_s_getreg((3 << 11) | 20) & 0xFu; }
#define XB_SPIN(cond, bar) do { unsigned _sp = 0; while (cond) { __builtin_amdgcn_s_sleep(1); \
    if ((++_sp & 255u) == 0u) { if (xb_ld(&(bar)[XB_TMO])) break; if (_sp > XB_SPIN_CAP) { atomicAdd(&(bar)[XB_TMO], 1u); break; } } } } while (0)

struct XcdBarrier {
    unsigned* bar; unsigned x;
    volatile LAS unsigned* st;
};

__device__ __forceinline__ XcdBarrier xcd_barrier_post(unsigned* bar, volatile LAS unsigned* st) {
    XcdBarrier b; b.bar = bar; b.x = xb_xcc_id(); b.st = st;
    if (threadIdx.x == 0) (void)xb_add(&bar[XB_XCNT(b.x)], 1u);
    return b;
}
__device__ __forceinline__ void xcd_barrier_complete(unsigned* bar, unsigned x, unsigned& nloc, unsigned& nx) {
    const unsigned G = gridDim.x * gridDim.y * gridDim.z;
    unsigned sum, cnt, mine, sp = 0u;
    for (;;) {
        sum = 0u; cnt = 0u; mine = 0u;
#pragma unroll
        for (unsigned j = 0; j < 16; ++j) { const unsigned c = xb_ld(&bar[XB_XCNT(j)]); sum += c; cnt += (c > 0u) ? 1u : 0u; mine = (j == x) ? c : mine; }
        if (sum == G) break;
        __builtin_amdgcn_s_sleep(1);
        if ((++sp & 255u) == 0u) { if (xb_ld(&bar[XB_TMO])) break; if (sp > XB_SPIN_CAP) { atomicAdd(&bar[XB_TMO], 1u); break; } }
    }
    nloc = mine > 0u ? mine : 1u; nx = cnt > 0u ? cnt : 1u;
}

__device__ __forceinline__ void xcd_barrier(const XcdBarrier& b) {
    asm volatile("s_waitcnt vmcnt(0)" ::: "memory");
    __syncthreads();
    if (threadIdx.x == 0) {
        unsigned* bar = b.bar;
        __builtin_amdgcn_s_waitcnt(0);
        unsigned nloc = b.st[0], nx = b.st[1];
        if (nloc == 0u) { xcd_barrier_complete(bar, b.x, nloc, nx); b.st[0] = nloc; b.st[1] = nx; }
        const unsigned old = xb_add(&bar[XB_XSUB(b.x)], 1u);
        const unsigned gen = old / nloc;
        if (old + 1u == (gen + 1u) * nloc) {
            __builtin_amdgcn_fence(__ATOMIC_RELEASE, "agent");
            asm volatile("s_waitcnt vmcnt(0)" ::: "memory");
            const unsigned og = xb_add(&bar[XB_TOP], 1u);
            const unsigned tg = og / nx;
            if (og + 1u == (tg + 1u) * nx) xb_add(&bar[XB_TOPGEN], 1u);
            else XB_SPIN(xb_ld(&bar[XB_TOPGEN]) == tg, bar);
            __builtin_amdgcn_fence(__ATOMIC_ACQUIRE, "agent");
            xb_add(&bar[XB_XGEN(b.x)], 1u);
            asm volatile("s_waitcnt vmcnt(0)" ::: "memory");
        } else {
            XB_SPIN(xb_ld(&bar[XB_XGEN(b.x)]) == gen, bar);
            __builtin_amdgcn_fence(__ATOMIC_ACQUIRE, "agent");
            asm volatile("s_waitcnt vmcnt(0)" ::: "memory");
        }
    }
    __syncthreads();
}

struct Args { const float* in[21]; float* out; unsigned char* ws; int ph_lo, ph_hi; };
enum { I_X = 0, I_WIN, I_LQ1, I_LK1, I_LQ2, I_LK2, I_SUBG, I_GLNG, I_GLNB, I_WSP, I_BSP, I_WOUT, I_LN1G, I_LN1B, I_WGATE, I_WUP, I_CONVW, I_CONVB, I_WDOWN, I_LN2G, I_LN2B };

__global__ void __launch_bounds__(512, 2) fwd(Args a) {
    extern __shared__ __attribute__((aligned(16))) unsigned char lds_raw[];
    LAS unsigned char* lds = (LAS unsigned char*)lds_raw;
    cg::grid_group grid = cg::this_grid();
    const int tid = threadIdx.x, lane = tid & 63, wave = __builtin_amdgcn_readfirstlane(tid >> 6);
    const int G = gridDim.x, bx = blockIdx.x;
    const int vcu = (G % 8 == 0) ? (bx % 8) * (G / 8) + bx / 8 : bx;
    unsigned char* ws = a.ws;
    bf16_t* WinT = (bf16_t*)(ws + WS_WIN); bf16_t* WoT = (bf16_t*)(ws + WS_WO); bf16_t* WguT = (bf16_t*)(ws + WS_WGU); bf16_t* WdT = (bf16_t*)(ws + WS_WD);
    float* ROPE = (float*)(ws + WS_ROPE); bf16_t* TRIL = (bf16_t*)(ws + WS_TRIL); bf16_t* X1B = (bf16_t*)(ws + WS_X1B);
    bf16_t* XB = (bf16_t*)(ws + WS_XB); bf16_t* QKV = (bf16_t*)(ws + WS_QKV); bf16_t* Zb = (bf16_t*)(ws + WS_Z); bf16_t* CAT = (bf16_t*)(ws + WS_CAT);
    bf16_t* Gb = (bf16_t*)(ws + WS_G); bf16_t* Ub = (bf16_t*)(ws + WS_U);
    const int lo = a.ph_lo, hi = a.ph_hi;
#define IN(k) (lo <= (k) && (k) < hi)
#define SEAM(k) do { if (IN(k) && IN((k) + 1)) { if ((k) == 0) { grid.sync(); bar = xcd_barrier_post(barw, MISC + 8); } else xcd_barrier(bar); } } while (0)
    unsigned* barw = (unsigned*)ws;
    volatile LAS unsigned* MISC = (volatile LAS unsigned*)(lds + 131072 + 320);
    if (tid < 32) MISC[tid] = 0u;
    __syncthreads();
    XcdBarrier bar; bar.bar = barw; bar.x = 0; bar.st = MISC + 8;

    if (IN(0)) {
        if (bx == 0) for (int i = tid; i < XCD_BAR_WORDS; i += 512) barw[i] = 0u;
        LAS float* scr = (LAS float*)(lds + wave * 16384);
        const int gw = vcu * 8 + wave, NGW = G * 8;
        constexpr int I_IN = (DM / 64) * (NIN / 32), I_O = (DM / 64) * (DM / 32), I_GU = (DM / 64) * (NGU / 32), I_D = (FF / 64) * (DM / 32);
        for (int it = gw; it < I_IN + I_O + I_GU + I_D; it += NGW) {
            int r = it;
            if (r < I_IN) { transpose_item<1>(a.in[I_WIN], nullptr, DM, NIN, NIN, WinT, scr, r, lane); continue; } r -= I_IN;
            if (r < I_O) { transpose_item<0>(a.in[I_WOUT], nullptr, DM, DM, DM, WoT, scr, r, lane); continue; } r -= I_O;
            if (r < I_GU) { transpose_item<2>(a.in[I_WGATE], a.in[I_WUP], DM, FF, NGU, WguT, scr, r, lane); continue; } r -= I_GU;
            transpose_item<0>(a.in[I_WDOWN], nullptr, FF, DM, DM, WdT, scr, r, lane);
        }
        const size_t gt = (size_t)bx * 512 + tid, NTH = (size_t)G * 512;
        for (size_t i = gt; i < (size_t)M * DM / 4; i += NTH) { const f32x4 v = ((const f32x4*)a.in[I_X])[i]; u32x2 w; w.x = cvt_pk_bf16(v.x, v.y); w.y = cvt_pk_bf16(v.z, v.w); ((u32x2*)XB)[i] = w; }
        for (size_t i = gt; i < (size_t)SEQ * 32; i += NTH) {
            const int pos = (int)(i >> 5), k = (int)(i & 31);
            const float inv = 1.0f / powf(10000.0f, (float)k * (1.0f / 32.0f));
            const float ang = (float)pos * inv;
            const double tw = 6.283185307179586476925; const double ad = (double)ang; const double n = __builtin_rint(ad * (1.0 / tw)); const float r = (float)(ad - n * tw);
            ROPE[pos * 64 + k] = cosf(r); ROPE[pos * 64 + 32 + k] = sinf(r);
        }
        for (size_t i = gt; i < (size_t)4 * 128 * 128; i += NTH) { const int s = (int)(i & 127), t = (int)((i >> 7) & 127); TRIL[i] = (bf16_t)f2bf(s <= t ? a.in[I_WSP][i] : 0.f); }
    }
    SEAM(0);
    if (IN(1)) {
        pg8::Gemm g{XB, WinT, M, NIN, DM}; pg8::StaticOrder S; S.init(M, NIN, G, bx);
        EpiIn E{QKV, Zb, ROPE};
        pg8::gemm_phase<EpiIn, pg8::StaticOrder, true, true>(lds, g, S, E);
    }
    SEAM(1);
    if (IN(2)) {
        float d1 = 0.f, d2 = 0.f;
        for (int i = 0; i < 64; ++i) { d1 += a.in[I_LQ1][i] * a.in[I_LK1][i]; d2 += a.in[I_LQ2][i] * a.in[I_LK2][i]; }
        const float lam = expf(d1) - expf(d2) + 0.2f;
        for (int sl = vcu; sl < 256; sl += G) {
            const int bh = sl >> 4, s = sl & 15;
            for (int i = 0; i < 4; ++i) { const int u = (i == 0) ? s : (i == 1) ? 31 - s : (i == 2) ? 32 + s : 63 - s; att::unit(lds, QKV, CAT, a.in[I_SUBG], lam, bh >> 2, bh & 3, u); }
        }
        for (int u = vcu; u < 1024; u += G) gm::unit(lds, Zb, CAT, TRIL, a.in[I_GLNG], a.in[I_GLNB], a.in[I_BSP], u >> 8, (u >> 2) & 63, u & 3);
    }
    SEAM(2);
    if (IN(3)) {
        pg8::Gemm g{CAT, WoT, M, DM, DM}; pg8::StaticOrder S; S.init(M, DM, G, bx);
        EpiRes E{a.in[I_X], a.out};
        pg8::gemm_phase<EpiRes, pg8::StaticOrder, true, true>(lds, g, S, E);
    }
    SEAM(3);
    if (IN(4)) { for (int m = vcu * 8 + wave; m < M; m += G * 8) ln_row(a.out + (size_t)m * DM, a.out + (size_t)m * DM, X1B + (size_t)m * DM, a.in[I_LN1G], a.in[I_LN1B], lane); }
    SEAM(4);
    if (IN(5)) {
        pg8::Gemm g{X1B, WguT, M, NGU, DM}; pg8::StaticOrder S; S.init(M, NGU, G, bx);
        EpiGU E{Gb, Ub};
        pg8::gemm_phase<EpiGU, pg8::StaticOrder, true, true>(lds, g, S, E);
    }
    SEAM(5);
    if (IN(6)) {
        const float* cw = a.in[I_CONVW]; const float* cb = a.in[I_CONVB];
        for (int task = bx * 512 + tid; task < (M / 32) * (FF / 8); task += G * 512) {
            const int cgp = task % (FF / 8), rr = task / (FF / 8), f0 = 8 * cgp, r0 = 32 * rr;
            float w0[8], w1[8], w2[8], bb[8], gm2[8], gm1[8];
#pragma unroll
            for (int i = 0; i < 8; ++i) { w0[i] = cw[f0 + i]; w1[i] = cw[FF + f0 + i]; w2[i] = cw[2 * FF + f0 + i]; bb[i] = cb[f0 + i]; }
            if ((r0 & (SEQ - 1)) != 0) {
                const u32x4 a2 = *(const u32x4*)(Gb + (size_t)(r0 - 2) * FF + f0), a1 = *(const u32x4*)(Gb + (size_t)(r0 - 1) * FF + f0);
                gm2[0] = bflo(a2.x); gm2[1] = bfhi(a2.x); gm2[2] = bflo(a2.y); gm2[3] = bfhi(a2.y); gm2[4] = bflo(a2.z); gm2[5] = bfhi(a2.z); gm2[6] = bflo(a2.w); gm2[7] = bfhi(a2.w);
                gm1[0] = bflo(a1.x); gm1[1] = bfhi(a1.x); gm1[2] = bflo(a1.y); gm1[3] = bfhi(a1.y); gm1[4] = bflo(a1.z); gm1[5] = bfhi(a1.z); gm1[6] = bflo(a1.w); gm1[7] = bfhi(a1.w);
            } else {
#pragma unroll
                for (int i = 0; i < 8; ++i) { gm2[i] = 0.f; gm1[i] = 0.f; }
            }
#pragma unroll 4
            for (int r = 0; r < 32; ++r) {
                const size_t off = (size_t)(r0 + r) * FF + f0;
                const u32x4 gw = *(const u32x4*)(Gb + off), uw = *(const u32x4*)(Ub + off);
                float gc[8], uu[8], o[8];
                gc[0] = bflo(gw.x); gc[1] = bfhi(gw.x); gc[2] = bflo(gw.y); gc[3] = bfhi(gw.y); gc[4] = bflo(gw.z); gc[5] = bfhi(gw.z); gc[6] = bflo(gw.w); gc[7] = bfhi(gw.w);
                uu[0] = bflo(uw.x); uu[1] = bfhi(uw.x); uu[2] = bflo(uw.y); uu[3] = bfhi(uw.y); uu[4] = bflo(uw.z); uu[5] = bfhi(uw.z); uu[6] = bflo(uw.w); uu[7] = bfhi(uw.w);
#pragma unroll
                for (int i = 0; i < 8; ++i) {
                    const float y = bb[i] + w0[i] * gm2[i] + w1[i] * gm1[i] + w2[i] * gc[i];
                    const float sg = __builtin_amdgcn_rcpf(1.0f + __builtin_amdgcn_exp2f(-1.4426950408889634f * y));
                    o[i] = y * sg * uu[i]; gm2[i] = gm1[i]; gm1[i] = gc[i];
                }
                u32x4 w; w.x = cvt_pk_bf16(o[0], o[1]); w.y = cvt_pk_bf16(o[2], o[3]); w.z = cvt_pk_bf16(o[4], o[5]); w.w = cvt_pk_bf16(o[6], o[7]);
                *(u32x4*)(Ub + off) = w;
            }
        }
    }
    SEAM(6);
    if (IN(7)) {
        pg8::Gemm g{Ub, WdT, M, DM, FF}; pg8::StaticOrder S; S.init(M, DM, G, bx);
        EpiRes E{a.out, a.out};
        pg8::gemm_phase<EpiRes, pg8::StaticOrder, true, true>(lds, g, S, E);
    }
    SEAM(7);
    if (IN(8)) { for (int m = vcu * 8 + wave; m < M; m += G * 8) ln_row(a.out + (size_t)m * DM, a.out + (size_t)m * DM, nullptr, a.in[I_LN2G], a.in[I_LN2B], lane); }
#undef IN
#undef SEAM
}

extern "C" void kernel_launch(void* const* d_in, const int* in_sizes, int n_in, void* d_out, int out_size, void* d_ws, size_t ws_size, hipStream_t stream) {
    static int grid = 0;
    if (grid == 0) {
        if (n_in != 21 || in_sizes[0] != M * DM || out_size != M * DM || ws_size < WS_END) { fprintf(stderr, "kernel_launch: unexpected shapes (n_in %d, in0 %d, out %d, ws %zu)\n", n_in, n_in > 0 ? in_sizes[0] : -1, out_size, ws_size); grid = -1; return; }
        int dev = 0, cus = 0, per_cu = 0;
        hipGetDevice(&dev); hipDeviceGetAttribute(&cus, hipDeviceAttributeMultiprocessorCount, dev);
        hipFuncSetAttribute((const void*)fwd, hipFuncAttributeMaxDynamicSharedMemorySize, LDS_BYTES);
        if (hipOccupancyMaxActiveBlocksPerMultiprocessor(&per_cu, (const void*)fwd, 512, LDS_BYTES) != hipSuccess || per_cu < 1) per_cu = 1;
        (void)hipGetLastError();
        grid = cus * per_cu;
        if (grid <= 0) grid = 256;
    }
    if (grid < 0) return;
    Args a{};
    for (int i = 0; i < 21; ++i) a.in[i] = (const float*)d_in[i];
    a.out = (float*)d_out; a.ws = (unsigned char*)d_ws;
#if MK_N_LAUNCHES == 1
    a.ph_lo = 0; a.ph_hi = NPHASE;
    void* args[] = {&a};
    hipError_t e = hipLaunchCooperativeKernel((const void*)fwd, dim3(grid), dim3(512), args, LDS_BYTES, stream);
    if (e != hipSuccess) fprintf(stderr, "cooperative launch failed: %s (grid %d)\n", hipGetErrorString(e), grid);
#else
    for (int p = 0; p < NPHASE; ++p) { a.ph_lo = p; a.ph_hi = p + 1; hipLaunchKernelGGL(fwd, dim3(grid), dim3(512), LDS_BYTES, stream, a); }
#endif
}
```

```cpp
#include <hip/hip_runtime.h>
#include <hip/hip_cooperative_groups.h>
#include <cstdio>
#include <cstdint>
namespace cg = cooperative_groups;
namespace pg8 {
#define PG8_LAS __attribute__((address_space(3)))
typedef unsigned short bf16_t;
typedef short bf16x8 __attribute__((ext_vector_type(8)));
typedef float f32x4 __attribute__((ext_vector_type(4)));
typedef unsigned u32x4 __attribute__((ext_vector_type(4)));
constexpr int BM = 256, BK = 64, HALF = 128, HTB = HALF * BK * 2  , STAGE_BYTES = 8 * HTB, NXCD = 8, WGM = 8;

__host__ __device__ __forceinline__ int lds_byte(int r, int c) { const int st = (r >> 4) * 2 + (c >> 5), rr = r & 15, cc = c & 31, ob = rr * 64 + cc * 2; return st * 1024 + (ob ^ (((ob >> 9) & 1) << 5)); }
__host__ __device__ __forceinline__ void stage_rc(int b, int& R, int& C) { const int st = b / 1024, sb = b % 1024, swz = sb ^ (((sb >> 9) & 1) << 5); R = (st >> 1) * 16 + swz / 64; C = (st & 1) * 32 + (swz % 64) / 2; }
__host__ __device__ __forceinline__ int perm32(int rho) { const int n = rho >> 4, i = rho & 15; return 8 * (i >> 2) + 4 * n + (i & 3); }

struct Unit { int pm, pn; };
struct Gemm { const bf16_t* A; const bf16_t* Bt; int M, N, K; };

struct StaticOrder {
    int nM, nN, nwg, G, c;
    __host__ __device__ void init(int M, int N, int G_, int c_) { nM = M / BM; nN = N / BM; nwg = nM * nN; G = G_; c = c_; }
    __host__ __device__ bool next(int i, Unit& u) const {
        const long L = (long)i * G + c; if (L >= nwg) return false;
        int wgid = (int)L; { const int q = nwg / NXCD, r = nwg % NXCD, xcd = wgid % NXCD, off = wgid / NXCD; wgid = (xcd < r ? xcd * (q + 1) : r * (q + 1) + (xcd - r) * q) + off; }
        const int nig = WGM * nN, gid = wgid / nig, fm = gid * WGM, gsz = (nM - fm) < WGM ? (nM - fm) : WGM;
        u.pm = fm + ((wgid % nig) % gsz); u.pn = (wgid % nig) / gsz; return true;
    }
    __device__ __forceinline__ void a_ready(const Unit&) const {}
    __device__ __forceinline__ void done(const Unit&) const {}
};

__device__ __forceinline__ unsigned cvt_pk_bf16(float lo, float hi) { unsigned r; asm volatile("v_cvt_pk_bf16_f32 %0, %1, %2" : "=v"(r) : "v"(lo), "v"(hi)); return r; }
typedef float f32x2 __attribute__((ext_vector_type(2)));
__device__ __forceinline__ f32x2 gelu_pk(f32x2 v) {
    const f32x2 av = __builtin_elementwise_abs(v), d = av * 0.2316418882f + 1.0f;
    f32x2 t; t.x = __builtin_amdgcn_rcpf(d.x); t.y = __builtin_amdgcn_rcpf(d.y);
    f32x2 q = t * 0.5307027145f + (-0.7265760135f); q = q * t + 0.7107068705f; q = q * t + (-0.142248368f); q = q * t + 0.127414796f; q = q * t;
    const f32x2 s = (v * v) * (-0.72134752044f);
    f32x2 e; e.x = __builtin_amdgcn_exp2f(s.x); e.y = __builtin_amdgcn_exp2f(s.y);
    const f32x2 m = v * (q * e), r = v - m;
    f32x2 o; o.x = v.x < 0.f ? m.x : r.x; o.y = v.y < 0.f ? m.y : r.y; return o;
}
template <class Epi, class Sched, bool ALIGN_EPI = false, bool SP2 = false>
__device__ __forceinline__ void gemm_phase(PG8_LAS unsigned char* lds, const Gemm g, const Sched& S, const Epi& E) {
    const int tid = threadIdx.x, wid = __builtin_amdgcn_readfirstlane(tid >> 6), lane = tid & 63, wr = wid >> 2, wc = wid & 3, fr = lane & 15, fq = lane >> 4;
    const int K = g.K, nt = K / BK;
    unsigned voffA[2], voffB[2];
#pragma unroll
    for (int i = 0; i < 2; ++i) { int R, C; stage_rc(tid * 16 + i * 8192, R, C); const int Rb = Epi::PERM ? ((R & ~31) + perm32(R & 31)) : R;
        voffA[i] = (unsigned)(R * K + C) * 2u; voffB[i] = (unsigned)(Rb * K + C) * 2u; }
    const size_t kstep = (size_t)(BK * 2);
    const size_t hstep = (size_t)HALF * K * 2;
    const size_t tstep = 2 * hstep;
    const unsigned ldsw = (unsigned)wid * 1024u;
    const int aoff = lds_byte(wr * 64 + fr, fq * 8), boff = lds_byte(wc * 32 + fr, fq * 8);
#define PG8_SA(b, h) (((b) * 2 + (h)) * HTB)
#define PG8_SB(b, h) ((4 + (b) * 2 + (h)) * HTB)
#define PG8_STAGE(bufoff, gbase, voff) do { _Pragma("unroll") for (int _i = 0; _i < 2; ++_i) \
        __builtin_amdgcn_global_load_lds((const unsigned*)((const char*)(gbase) + (voff)[_i]), (PG8_LAS unsigned*)(lds + (bufoff) + ldsw + _i * 8192), 16, 0, 0); } while (0)
#define PG8_LDA(dst, b, h) do { _Pragma("unroll") for (int m = 0; m < 4; ++m) _Pragma("unroll") for (int k = 0; k < 2; ++k) dst[m][k] = *(const PG8_LAS bf16x8*)(lds + PG8_SA(b, h) + aoff + m * 2048 + k * 1024); } while (0)
#define PG8_LDB(dst, b, h) do { _Pragma("unroll") for (int n = 0; n < 2; ++n) _Pragma("unroll") for (int k = 0; k < 2; ++k) dst[n][k] = *(const PG8_LAS bf16x8*)(lds + PG8_SB(b, h) + boff + n * 2048 + k * 1024); } while (0)
#define PG8_MMA(ai, bj, At, Bt) do { __builtin_amdgcn_s_setprio(1); _Pragma("unroll") for (int m = 0; m < 4; ++m) _Pragma("unroll") for (int n = 0; n < 2; ++n) _Pragma("unroll") for (int k = 0; k < 2; ++k) \
        acc[ai][bj][m][n] = __builtin_amdgcn_mfma_f32_16x16x32_bf16(Bt[n][k], At[m][k], acc[ai][bj][m][n], 0, 0, 0); __builtin_amdgcn_s_setprio(0); } while (0)
#define PG8_WAIT_V(n) asm volatile("s_waitcnt vmcnt(" #n ")" ::: "memory")
#define PG8_WAIT_L(n) asm volatile("s_waitcnt lgkmcnt(" #n ")" ::: "memory")
#define PG8_BAR __builtin_amdgcn_s_barrier()
#define PG8_SCHED __builtin_amdgcn_sched_barrier(0)
    Unit cur, nxt; int ui = 0;
    if (!S.next(0, cur)) return;
    f32x4 acc[2][2][4][2];
#pragma unroll
    for (int a = 0; a < 2; ++a)
#pragma unroll
        for (int b = 0; b < 2; ++b)
#pragma unroll
            for (int m = 0; m < 4; ++m)
#pragma unroll
                for (int n = 0; n < 2; ++n) acc[a][b][m][n] = (f32x4){0.f, 0.f, 0.f, 0.f};
    bf16x8 At[4][2], B0[2][2], B1[2][2];
    const char* cA = (const char*)g.A + (size_t)cur.pm * tstep; const char* cB = (const char*)g.Bt + (size_t)cur.pn * tstep;
    S.a_ready(cur);
    if constexpr (SP2) {
        PG8_STAGE(PG8_SB(0, 0), cB, voffB); PG8_STAGE(PG8_SB(0, 1), cB + hstep, voffB); PG8_STAGE(PG8_SA(0, 0), cA, voffA); PG8_STAGE(PG8_SA(0, 1), cA + hstep, voffA);
        if (wr == 1) PG8_BAR;
        PG8_WAIT_V(2); PG8_BAR;
        PG8_STAGE(PG8_SB(1, 0), cB + kstep, voffB); PG8_STAGE(PG8_SA(1, 0), cA + kstep, voffA); PG8_STAGE(PG8_SB(1, 1), cB + hstep + kstep, voffB);
        PG8_WAIT_V(6); PG8_BAR;
    } else {
        PG8_STAGE(PG8_SB(0, 0), cB, voffB); PG8_STAGE(PG8_SA(0, 0), cA, voffA); PG8_STAGE(PG8_SB(0, 1), cB + hstep, voffB); PG8_STAGE(PG8_SA(0, 1), cA + hstep, voffA);
        if (wr == 1) PG8_BAR;
        PG8_WAIT_V(4); PG8_BAR;
        PG8_STAGE(PG8_SB(1, 0), cB + kstep, voffB); PG8_STAGE(PG8_SA(1, 0), cA + kstep, voffA); PG8_STAGE(PG8_SB(1, 1), cB + hstep + kstep, voffB);
        PG8_WAIT_V(6); PG8_BAR;
    }
    for (;;) {
        const bool has_next = S.next(ui + 1, nxt);
        const char* nA = has_next ? (const char*)g.A + (size_t)nxt.pm * tstep : cA; const char* nB = has_next ? (const char*)g.Bt + (size_t)nxt.pn * tstep : cB;
        for (int t = 0; t < nt; t += 2) {
            const bool last = (t == nt - 2);
            const char* a1 = cA + (size_t)(t + 1) * kstep;
            const char* a2 = last ? nA : cA + (size_t)(t + 2) * kstep; const char* b2 = last ? nB : cB + (size_t)(t + 2) * kstep;
            const char* a3 = a2 + kstep; const char* b3 = b2 + kstep;
            if (last && has_next) S.a_ready(nxt);
            if constexpr (SP2) {
            PG8_LDB(B0, 0, 0); PG8_LDB(B1, 0, 1); PG8_SCHED; PG8_LDA(At, 0, 0); PG8_STAGE(PG8_SA(1, 1), a1 + hstep, voffA);
            PG8_WAIT_V(8); PG8_WAIT_L(0); PG8_BAR; PG8_MMA(0, 0, At, B0); PG8_MMA(0, 1, At, B1); PG8_BAR; PG8_SCHED;
            PG8_LDA(At, 0, 1); PG8_STAGE(PG8_SB(0, 0), b2, voffB); PG8_STAGE(PG8_SB(0, 1), b2 + hstep, voffB); PG8_STAGE(PG8_SA(0, 0), a2, voffA);
            PG8_WAIT_V(8); PG8_WAIT_L(0); PG8_BAR; PG8_MMA(1, 0, At, B0); PG8_MMA(1, 1, At, B1); PG8_BAR; PG8_SCHED;
            PG8_LDB(B0, 1, 0); PG8_LDB(B1, 1, 1); PG8_SCHED; PG8_LDA(At, 1, 0); PG8_STAGE(PG8_SA(0, 1), a2 + hstep, voffA);
            PG8_WAIT_V(8); PG8_WAIT_L(0); PG8_BAR; PG8_MMA(0, 0, At, B0); PG8_MMA(0, 1, At, B1); PG8_BAR; PG8_SCHED;
            PG8_LDA(At, 1, 1); PG8_STAGE(PG8_SB(1, 0), b3, voffB); PG8_STAGE(PG8_SB(1, 1), b3 + hstep, voffB); PG8_STAGE(PG8_SA(1, 0), a3, voffA);
            PG8_WAIT_V(8); PG8_WAIT_L(0); PG8_BAR; PG8_MMA(1, 0, At, B0); PG8_MMA(1, 1, At, B1); PG8_BAR; PG8_SCHED;
            } else {
            PG8_LDB(B0, 0, 0); PG8_SCHED; PG8_LDA(At, 0, 0); PG8_STAGE(PG8_SA(1, 1), a1 + hstep, voffA);
            PG8_WAIT_L(8); PG8_BAR; PG8_WAIT_L(0); PG8_MMA(0, 0, At, B0); PG8_BAR; PG8_SCHED;
            PG8_LDB(B1, 0, 1); PG8_STAGE(PG8_SB(0, 0), b2, voffB);
            PG8_BAR; PG8_WAIT_L(0); PG8_MMA(0, 1, At, B1); PG8_BAR;
            PG8_LDA(At, 0, 1); PG8_STAGE(PG8_SA(0, 0), a2, voffA);
            PG8_BAR; PG8_WAIT_L(0); PG8_MMA(1, 0, At, B0); PG8_BAR; PG8_SCHED;
            PG8_STAGE(PG8_SB(0, 1), b2 + hstep, voffB);
            PG8_WAIT_V(6); PG8_BAR; PG8_MMA(1, 1, At, B1); PG8_BAR;
            PG8_LDB(B0, 1, 0); PG8_SCHED; PG8_LDA(At, 1, 0); PG8_STAGE(PG8_SA(0, 1), a2 + hstep, voffA);
            PG8_WAIT_L(8); PG8_BAR; PG8_WAIT_L(0); PG8_MMA(0, 0, At, B0); PG8_BAR; PG8_SCHED;
            PG8_LDB(B1, 1, 1); PG8_STAGE(PG8_SB(1, 0), b3, voffB);
            PG8_BAR; PG8_WAIT_L(0); PG8_MMA(0, 1, At, B1); PG8_BAR;
            PG8_LDA(At, 1, 1); PG8_STAGE(PG8_SA(1, 0), a3, voffA);
            PG8_BAR; PG8_WAIT_L(0); PG8_MMA(1, 0, At, B0); PG8_BAR; PG8_SCHED;
            PG8_STAGE(PG8_SB(1, 1), b3 + hstep, voffB);
            PG8_WAIT_V(6); PG8_BAR; PG8_MMA(1, 1, At, B1); PG8_BAR;
            }
        }
        if constexpr (ALIGN_EPI) { if (wr == 0) PG8_BAR; }
        if constexpr (!Epi::AFTER_DRAIN) { E(acc, cur, wr, wc, fr, fq); S.done(cur); }
        if (!has_next) break;
#pragma unroll
        for (int a = 0; a < 2; ++a)
#pragma unroll
            for (int b = 0; b < 2; ++b)
#pragma unroll
                for (int m = 0; m < 4; ++m)
#pragma unroll
                    for (int n = 0; n < 2; ++n) acc[a][b][m][n] = (f32x4){0.f, 0.f, 0.f, 0.f};
        cur = nxt; cA = nA; cB = nB; ++ui;
        if constexpr (ALIGN_EPI) { if (wr == 1) PG8_BAR; }
    }
    PG8_WAIT_V(0);
    if constexpr (!ALIGN_EPI) { if (wr == 0) PG8_BAR; }
    PG8_BAR;
    if constexpr (Epi::AFTER_DRAIN) { E.fused(acc, cur, wr, wc, fr, fq, lds, wid, lane); S.done(cur); }
#undef PG8_SA
#undef PG8_SB
#undef PG8_STAGE
#undef PG8_LDA
#undef PG8_LDB
#undef PG8_MMA
#undef PG8_WAIT_V
#undef PG8_WAIT_L
#undef PG8_BAR
#undef PG8_SCHED
}
}

#ifndef MK_N_LAUNCHES
#define MK_N_LAUNCHES 1
#endif
constexpr int BATCH = 4, SEQ = 8192, DM = 1024, M = BATCH * SEQ, NIN = 2560, FF = 2816, NGU = 2 * FF, QKVP = 1536;
constexpr float LN_EPS = 1e-5f;
constexpr float ALPHA = 1.189207115002721f;
constexpr float C2 = 0.125f * 1.4426950408889634f;
constexpr int NPHASE = 9;
constexpr size_t MiB = 1u << 20;
constexpr size_t WS_WIN = 1 * MiB, WS_WO = 6 * MiB, WS_WGU = 8 * MiB, WS_WD = 19 * MiB, WS_ROPE = 25 * MiB, WS_TRIL = 27 * MiB, WS_X1B = 28 * MiB;
constexpr size_t WS_BIG = 92 * MiB;
constexpr size_t WS_XB = WS_BIG, WS_QKV = WS_BIG + 64 * MiB, WS_Z = WS_BIG + 160 * MiB, WS_CAT = WS_BIG + 224 * MiB;
constexpr size_t WS_G = WS_BIG, WS_U = WS_BIG + 176 * MiB, WS_END = WS_BIG + 352 * MiB;
constexpr int LDS_BYTES = 147456;

#define LAS __attribute__((address_space(3)))
typedef unsigned short bf16_t;
typedef short bf16x8 __attribute__((ext_vector_type(8)));
typedef short s16x4 __attribute__((ext_vector_type(4)));
typedef float f32x4 __attribute__((ext_vector_type(4)));
typedef float f32x2 __attribute__((ext_vector_type(2)));
typedef unsigned u32x4 __attribute__((ext_vector_type(4)));
typedef unsigned u32x2 __attribute__((ext_vector_type(2)));
typedef __bf16 bf16x2_t __attribute__((ext_vector_type(2)));
__device__ __forceinline__ unsigned cvt_pk_bf16(float lo, float hi) { f32x2 v = {lo, hi}; bf16x2_t b = __builtin_convertvector(v, bf16x2_t); return __builtin_bit_cast(unsigned, b); }
using pg8::Unit;

__device__ __forceinline__ float wave_sum(float v) {
#pragma unroll
    for (int o = 1; o < 64; o <<= 1) v += __shfl_xor(v, o);
    return v;
}
__device__ __forceinline__ float bf2f(unsigned short h) { return __uint_as_float((unsigned)h << 16); }
__device__ __forceinline__ float bflo(unsigned w) { return __uint_as_float(w << 16); }
__device__ __forceinline__ float bfhi(unsigned w) { return __uint_as_float(w & 0xffff0000u); }

struct EpiIn {
    static constexpr bool PERM = true, AFTER_DRAIN = false;
    bf16_t* QKV; bf16_t* Z; const float* rope;
    __device__ __forceinline__ void operator()(const f32x4 (&acc)[2][2][4][2], const Unit& u, int wr, int wc, int fr, int fq) const {
        const int row0 = u.pm * 256 + wr * 64 + fr, colt = u.pn * 256;
#pragma unroll
        for (int ai = 0; ai < 2; ++ai)
#pragma unroll
            for (int m = 0; m < 4; ++m) {
                const int row = row0 + ai * 128 + m * 16;
#pragma unroll
                for (int bj = 0; bj < 2; ++bj) {
                    const int c0 = colt + bj * 128 + wc * 32 + 8 * fq;
                    f32x4 v0 = acc[ai][bj][m][0], v1 = acc[ai][bj][m][1];
                    if (colt < 1024) {
                        const int d = (c0 & 63) >> 1, pos = row & (SEQ - 1);
                        const f32x4 cs = *(const f32x4*)(rope + pos * 64 + d), sn = *(const f32x4*)(rope + pos * 64 + 32 + d);
                        f32x4 lo = v0 * cs - v1 * sn, hi = v1 * cs + v0 * sn;
                        if (colt < 512) { lo = lo * C2; hi = hi * C2; }
                        bf16_t* p = QKV + (size_t)row * QKVP + (c0 & ~63) + d;
                        u32x2 a, b; a.x = cvt_pk_bf16(lo[0], lo[1]); a.y = cvt_pk_bf16(lo[2], lo[3]); b.x = cvt_pk_bf16(hi[0], hi[1]); b.y = cvt_pk_bf16(hi[2], hi[3]);
                        *(u32x2*)p = a; *(u32x2*)(p + 32) = b;
                    } else if (colt < 1536) {
                        u32x4 w; w.x = cvt_pk_bf16(v0[0], v0[1]); w.y = cvt_pk_bf16(v0[2], v0[3]); w.z = cvt_pk_bf16(v1[0], v1[1]); w.w = cvt_pk_bf16(v1[2], v1[3]);
                        *(u32x4*)(QKV + (size_t)row * QKVP + c0) = w;
                    } else {
                        const pg8::f32x2 a = pg8::gelu_pk((pg8::f32x2){v0[0], v0[1]}), b = pg8::gelu_pk((pg8::f32x2){v0[2], v0[3]}), c = pg8::gelu_pk((pg8::f32x2){v1[0], v1[1]}), e = pg8::gelu_pk((pg8::f32x2){v1[2], v1[3]});
                        u32x4 w; w.x = cvt_pk_bf16(a.x, a.y); w.y = cvt_pk_bf16(b.x, b.y); w.z = cvt_pk_bf16(c.x, c.y); w.w = cvt_pk_bf16(e.x, e.y);
                        *(u32x4*)(Z + (size_t)row * 1024 + (c0 - 1536)) = w;
                    }
                }
            }
    }
};
struct EpiRes {
    static constexpr bool PERM = false, AFTER_DRAIN = false;
    const float* base; float* out;
    __device__ __forceinline__ void operator()(const f32x4 (&acc)[2][2][4][2], const Unit& u, int wr, int wc, int fr, int fq) const {
        const int row0 = u.pm * 256 + wr * 64 + fr, col0 = u.pn * 256 + wc * 32 + 4 * fq;
#pragma unroll
        for (int ai = 0; ai < 2; ++ai)
#pragma unroll
            for (int m = 0; m < 4; ++m) {
                const size_t off = (size_t)(row0 + ai * 128 + m * 16) * DM + col0;
#pragma unroll
                for (int bj = 0; bj < 2; ++bj)
#pragma unroll
                    for (int n = 0; n < 2; ++n) { const f32x4 bs = *(const f32x4*)(base + off + bj * 128 + n * 16); *(f32x4*)(out + off + bj * 128 + n * 16) = bs * ALPHA + acc[ai][bj][m][n]; }
            }
    }
};
struct EpiGU {
    static constexpr bool PERM = true, AFTER_DRAIN = false;
    bf16_t* G; bf16_t* U;
    __device__ __forceinline__ void operator()(const f32x4 (&acc)[2][2][4][2], const Unit& u, int wr, int wc, int fr, int fq) const {
        const int row0 = u.pm * 256 + wr * 64 + fr, f0 = u.pn * 128 + wc * 32 + 8 * fq;
#pragma unroll
        for (int ai = 0; ai < 2; ++ai)
#pragma unroll
            for (int m = 0; m < 4; ++m) {
                const size_t off = (size_t)(row0 + ai * 128 + m * 16) * FF + f0;
#pragma unroll
                for (int bj = 0; bj < 2; ++bj) {
                    const f32x4 v0 = acc[ai][bj][m][0], v1 = acc[ai][bj][m][1];
                    u32x4 w; w.x = cvt_pk_bf16(v0[0], v0[1]); w.y = cvt_pk_bf16(v0[2], v0[3]); w.z = cvt_pk_bf16(v1[0], v1[1]); w.w = cvt_pk_bf16(v1[2], v1[3]);
                    *(u32x4*)((bj ? U : G) + off) = w;
                }
            }
    }
};

__device__ __forceinline__ unsigned f2bf(float f) { unsigned u = __builtin_bit_cast(unsigned, f); return (u + 0x7fffu + ((u >> 16) & 1u)) >> 16; }
__device__ __forceinline__ unsigned pk2(float lo, float hi) { return f2bf(lo) | (f2bf(hi) << 16); }
template <int MODE> __device__ __forceinline__ const float* wsrc(const float* W, const float* W2, int j, int& N) {
    if (MODE == 1) { if (j < 1024) { const int jj = j & 63; j = (j - jj) + 32 * ((jj >> 2) & 1) + 4 * (jj >> 3) + (jj & 3); } return W + j; }
    if (MODE == 2) { const int pn = j >> 8, bj = (j >> 7) & 1, f = (pn << 7) + (j & 127); return (bj ? W2 : W) + f; }
    return W + j;
}
template <int MODE> __device__ __forceinline__ void transpose_item(const float* W, const float* W2, int K, int N, int NOUT, bf16_t* WT, LAS float* scr, int item, int lane) {
    const int nblk = NOUT / 32, kb = item / nblk, nb = item % nblk, k0 = 64 * kb, n0 = 32 * nb;
    int Nn = N; const float* src = wsrc<MODE>(W, W2, n0 + (lane & 31), Nn);
#pragma unroll 8
    for (int i = 0; i < 32; ++i) { const int kk = 2 * i + (lane >> 5); scr[kk * 33 + (lane & 31)] = src[(size_t)(k0 + kk) * N]; }
    asm volatile("s_waitcnt lgkmcnt(0)" ::: "memory");
    const int c = lane & 7;
#pragma unroll
    for (int j = 0; j < 4; ++j) { const int n = (lane >> 3) + 8 * j; const LAS float* s = scr + (8 * c) * 33 + n;
        u32x4 o; o.x = pk2(s[0 * 33], s[1 * 33]); o.y = pk2(s[2 * 33], s[3 * 33]); o.z = pk2(s[4 * 33], s[5 * 33]); o.w = pk2(s[6 * 33], s[7 * 33]);
        *(u32x4*)(WT + (size_t)(n0 + n) * K + k0 + 8 * c) = o; }
    asm volatile("s_waitcnt lgkmcnt(0)" ::: "memory");
}
__device__ __forceinline__ void ln_row(const float* in, float* outf, bf16_t* outb, const float* g, const float* b, int lane) {
    const f32x4* xr = (const f32x4*)in + lane;
    f32x4 v[4]; float s = 0.f;
#pragma unroll
    for (int j = 0; j < 4; ++j) { v[j] = xr[64 * j]; s += (v[j].x + v[j].y) + (v[j].z + v[j].w); }
    const float mean = wave_sum(s) * (1.f / DM); float s2 = 0.f;
#pragma unroll
    for (int j = 0; j < 4; ++j) { v[j] = v[j] - mean; s2 += (v[j].x * v[j].x + v[j].y * v[j].y) + (v[j].z * v[j].z + v[j].w * v[j].w); }
    const float rstd = 1.f / sqrtf(wave_sum(s2) * (1.f / DM) + LN_EPS);
#pragma unroll
    for (int j = 0; j < 4; ++j) {
        const f32x4 gv = ((const f32x4*)g)[lane + 64 * j], bv = ((const f32x4*)b)[lane + 64 * j];
        const f32x4 y = v[j] * rstd * gv + bv;
        if (outf) ((f32x4*)outf)[lane + 64 * j] = y;
        if (outb) { u32x2 w; w.x = cvt_pk_bf16(y.x, y.y); w.y = cvt_pk_bf16(y.z, y.w); ((u32x2*)outb)[lane + 64 * j] = w; }
    }
}

namespace att {
constexpr int KB = 8192, VSTR = 288, VB = 64 * VSTR, KSTAGE = 2 * KB, VOFF = 2 * KSTAGE;
__device__ __forceinline__ s16x4 vtr(const LAS unsigned char* p) { return __builtin_bit_cast(s16x4, __builtin_amdgcn_ds_read_tr16_b64_v4i16((LAS s16x4*)p)); }
#define ATT_MFMA __builtin_amdgcn_mfma_f32_16x16x32_bf16
__device__ __forceinline__ float max16(const f32x4 (&s)[4]) {
    float a = fmaxf(fmaxf(s[0][0], s[0][1]), fmaxf(s[0][2], s[0][3]));
#pragma unroll
    for (int T = 1; T < 4; ++T) a = fmaxf(fmaxf(a, s[T][0]), fmaxf(fmaxf(s[T][1], s[T][2]), s[T][3]));
    return a;
}
__device__ __forceinline__ float rowmax16(const f32x4 (&s)[4]) { float a = max16(s); a = fmaxf(a, __shfl_xor(a, 16)); a = fmaxf(a, __shfl_xor(a, 32)); return a; }
__device__ __forceinline__ void rescale(f32x4 (&s)[4], float& negm, f32x4 (&O)[8], f32x4& L) {
    const float dl = fmaxf(rowmax16(s), 0.f), f = __builtin_amdgcn_exp2f(-dl);
#pragma unroll
    for (int T = 0; T < 4; ++T) s[T] = s[T] - dl;
    negm = negm - dl; L = L * f;
#pragma unroll
    for (int t = 0; t < 8; ++t) O[t] = O[t] * f;
}

__device__ __forceinline__ void unit(LAS unsigned char* lds, const bf16_t* QKV, bf16_t* CAT, const float* subg, float lam, int b, int h, int u) {
    const int tid = threadIdx.x, lane = tid & 63, wid = __builtin_amdgcn_readfirstlane(tid >> 6), l15 = lane & 15, quad = lane >> 4;
    const size_t rowbase = (size_t)b * SEQ;
    const int q0 = 128 * u + 16 * wid, mychunk = q0 >> 6, NT = 2 * u + 2;
    const bf16_t* qp = QKV + (rowbase + q0 + l15) * QKVP + (2 * h) * 64 + 8 * quad;
    bf16x8 q1[2], q2[2];
    q1[0] = *(const bf16x8*)(qp); q1[1] = *(const bf16x8*)(qp + 32); q2[0] = *(const bf16x8*)(qp + 64); q2[1] = *(const bf16x8*)(qp + 96);
    const int pkey = 8 * wid + (lane >> 3), pchunk = (lane & 7) ^ (pkey & 7);
    const bf16_t* kg = QKV + (rowbase + pkey) * QKVP + 512 + (2 * h) * 64 + pchunk * 8;
    const bf16_t* vg = QKV + rowbase * QKVP + 1024 + h * 128;
    unsigned vsrc[3];
#pragma unroll
    for (int i = 0; i < 3; ++i) { const int c = 64 * (wid + 8 * i) + lane, row = c / 18, ch = c % 18; vsrc[i] = (unsigned)((row < 64 ? row : 0) * QKVP + (ch < 16 ? ch : 0) * 8); }
#define ATT_DMAK(j) do { const bf16_t* g_ = kg + (size_t)(j) * 64 * QKVP; LAS unsigned char* d_ = lds + ((j) & 1) * KSTAGE + wid * 1024; \
        __builtin_amdgcn_global_load_lds((const unsigned*)g_, (LAS unsigned*)d_, 16, 0, 0); __builtin_amdgcn_global_load_lds((const unsigned*)(g_ + 64), (LAS unsigned*)(d_ + KB), 16, 0, 0); } while (0)
#define ATT_DMAV(j) do { const bf16_t* g_ = vg + (size_t)(j) * 64 * QKVP; LAS unsigned char* d_ = lds + VOFF + ((j) & 1) * VB + wid * 1024; \
        __builtin_amdgcn_global_load_lds((const unsigned*)(g_ + vsrc[0]), (LAS unsigned*)d_, 16, 0, 0); __builtin_amdgcn_global_load_lds((const unsigned*)(g_ + vsrc[1]), (LAS unsigned*)(d_ + 8192), 16, 0, 0); \
        if (wid < 2) __builtin_amdgcn_global_load_lds((const unsigned*)(g_ + vsrc[2]), (LAS unsigned*)(d_ + 16384), 16, 0, 0); } while (0)
#define ATT_DRAIN() asm volatile("s_waitcnt vmcnt(0)" ::: "memory")
    f32x4 O1[8], O2[8], L1 = (f32x4){0.f, 0.f, 0.f, 0.f}, L2 = L1; float nm1 = 0.f, nm2 = 0.f;
#pragma unroll
    for (int t = 0; t < 8; ++t) { O1[t] = (f32x4){0.f, 0.f, 0.f, 0.f}; O2[t] = (f32x4){0.f, 0.f, 0.f, 0.f}; }
    const unsigned koff0 = l15 * 128 + 16 * (quad ^ (l15 & 7)), koff1 = l15 * 128 + 16 * ((4 + quad) ^ (l15 & 7));
    const unsigned voff = VOFF + (4 * quad + (l15 >> 2)) * VSTR + (l15 & 3) * 8;
    const bf16x8 ones = (bf16x8){(short)0x3F80, (short)0x3F80, (short)0x3F80, (short)0x3F80, (short)0x3F80, (short)0x3F80, (short)0x3F80, (short)0x3F80};
    f32x4 SA1[4], SA2[4], SB1[4], SB2[4];
#define ATT_QK(S1_, S2_, T, Bk) do { \
        const bf16x8 a0_ = *(const LAS bf16x8*)((Bk) + (T) * 2048 + koff0), a1_ = *(const LAS bf16x8*)((Bk) + (T) * 2048 + koff1); \
        const bf16x8 c0_ = *(const LAS bf16x8*)((Bk) + KB + (T) * 2048 + koff0), c1_ = *(const LAS bf16x8*)((Bk) + KB + (T) * 2048 + koff1); \
        S1_[T] = ATT_MFMA(a0_, q1[0], ((f32x4){nm1, nm1, nm1, nm1}), 0, 0, 0); S2_[T] = ATT_MFMA(c0_, q2[0], ((f32x4){nm2, nm2, nm2, nm2}), 0, 0, 0); \
        S1_[T] = ATT_MFMA(a1_, q1[1], S1_[T], 0, 0, 0); S2_[T] = ATT_MFMA(c1_, q2[1], S2_[T], 0, 0, 0); } while (0)
    ATT_DMAK(0); ATT_DMAV(0); ATT_DMAK(1); ATT_DRAIN();
    __syncthreads();
#pragma unroll
    for (int T = 0; T < 4; ++T) ATT_QK(SA1, SA2, T, lds);
    { const float r1 = rowmax16(SA1), r2 = rowmax16(SA2);
#pragma unroll
      for (int T = 0; T < 4; ++T) { SA1[T] = SA1[T] - r1; SA2[T] = SA2[T] - r2; }
      nm1 -= r1; nm2 -= r2; }
    __syncthreads();
#define ATT_STEP(C1, C2, N1, N2, j) do { \
        if ((j) + 2 < NT) ATT_DMAK((j) + 2); \
        if ((j) + 1 < NT) ATT_DMAV((j) + 1); \
        if ((j) <= mychunk) { \
            const LAS unsigned char* Bk_ = lds + (((j) + 1) & 1) * KSTAGE; const LAS unsigned char* Bv_ = lds + ((j) & 1) * VB; \
            const bool nxt_ = ((j) + 1 <= mychunk); \
            if (__any(fmaxf(max16(C1), max16(C2)) > 8.f)) { rescale(C1, nm1, O1, L1); rescale(C2, nm2, O2, L2); } \
            unsigned w1_[8], w2_[8]; \
            _Pragma("unroll") for (int T = 0; T < 4; ++T) { \
                if (nxt_) ATT_QK(N1, N2, T, Bk_); \
                w1_[2 * T] = cvt_pk_bf16(__builtin_amdgcn_exp2f(C1[T][0]), __builtin_amdgcn_exp2f(C1[T][1])); w1_[2 * T + 1] = cvt_pk_bf16(__builtin_amdgcn_exp2f(C1[T][2]), __builtin_amdgcn_exp2f(C1[T][3])); \
                w2_[2 * T] = cvt_pk_bf16(__builtin_amdgcn_exp2f(C2[T][0]), __builtin_amdgcn_exp2f(C2[T][1])); w2_[2 * T + 1] = cvt_pk_bf16(__builtin_amdgcn_exp2f(C2[T][2]), __builtin_amdgcn_exp2f(C2[T][3])); } \
            _Pragma("unroll") for (int ks = 0; ks < 2; ++ks) { \
                const bf16x8 P1_ = __builtin_bit_cast(bf16x8, (u32x4){w1_[4 * ks], w1_[4 * ks + 1], w1_[4 * ks + 2], w1_[4 * ks + 3]}); \
                const bf16x8 P2_ = __builtin_bit_cast(bf16x8, (u32x4){w2_[4 * ks], w2_[4 * ks + 1], w2_[4 * ks + 2], w2_[4 * ks + 3]}); \
                L1 = ATT_MFMA(ones, P1_, L1, 0, 0, 0); L2 = ATT_MFMA(ones, P2_, L2, 0, 0, 0); \
                _Pragma("unroll") for (int Td = 0; Td < 8; ++Td) { \
                    const s16x4 lo_ = vtr(Bv_ + voff + (32 * ks) * VSTR + 32 * Td), hi_ = vtr(Bv_ + voff + (32 * ks + 16) * VSTR + 32 * Td); \
                    const bf16x8 vf_ = (bf16x8){lo_[0], lo_[1], lo_[2], lo_[3], hi_[0], hi_[1], hi_[2], hi_[3]}; \
                    O1[Td] = ATT_MFMA(vf_, P1_, O1[Td], 0, 0, 0); O2[Td] = ATT_MFMA(vf_, P2_, O2[Td], 0, 0, 0); } } \
        } \
        ATT_DRAIN(); __syncthreads(); } while (0)
    for (int j = 0; j < NT; j += 2) { ATT_STEP(SA1, SA2, SB1, SB2, j); ATT_STEP(SB1, SB2, SA1, SA2, j + 1); }
#undef ATT_STEP
#undef ATT_QK
#undef ATT_DMAK
#undef ATT_DMAV
#undef ATT_DRAIN
    const float r1 = 1.f / L1[0], r2 = lam / L2[0]; float ss = 0.f;
#pragma unroll
    for (int t = 0; t < 8; ++t) { O1[t] = O1[t] * r1 - O2[t] * r2; ss += (O1[t][0] * O1[t][0] + O1[t][1] * O1[t][1]) + (O1[t][2] * O1[t][2] + O1[t][3] * O1[t][3]); }
    ss += __shfl_xor(ss, 16); ss += __shfl_xor(ss, 32);
    const float rn = 0.8f / sqrtf(ss * (1.f / 128.f) + LN_EPS);
    bf16_t* op = CAT + (rowbase + q0 + l15) * DM + h * 128 + 4 * quad;
#pragma unroll
    for (int t = 0; t < 8; ++t) { const f32x4 gv = *(const f32x4*)(subg + 16 * t + 4 * quad); const f32x4 y = O1[t] * rn * gv;
        u32x2 w; w.x = cvt_pk_bf16(y[0], y[1]); w.y = cvt_pk_bf16(y[2], y[3]); *(u32x2*)(op + 16 * t) = w; }
}
}

namespace gm {
constexpr int VSTR = 288;
__device__ __forceinline__ void unit(LAS unsigned char* lds, const bf16_t* Z, bf16_t* CAT, const bf16_t* TRIL, const float* lng, const float* lnb, const float* bs, int b, int c, int g) {
    const int tid = threadIdx.x, lane = tid & 63, wid = __builtin_amdgcn_readfirstlane(tid >> 6), l15 = lane & 15, quad = lane >> 4;
    const size_t row0 = (size_t)b * SEQ + 128 * c;
    {
        const int s = tid >> 2, seg = tid & 3;
        const bf16_t* zp = Z + (row0 + s) * 1024 + 512 + 128 * g + 32 * seg;
        float v[32];
#pragma unroll
        for (int i = 0; i < 4; ++i) { const u32x4 w = *(const u32x4*)(zp + 8 * i);
            v[8 * i + 0] = bflo(w.x); v[8 * i + 1] = bfhi(w.x); v[8 * i + 2] = bflo(w.y); v[8 * i + 3] = bfhi(w.y); v[8 * i + 4] = bflo(w.z); v[8 * i + 5] = bfhi(w.z); v[8 * i + 6] = bflo(w.w); v[8 * i + 7] = bfhi(w.w); }
        float sm = 0.f;
#pragma unroll
        for (int i = 0; i < 32; ++i) sm += v[i];
        sm += __shfl_xor(sm, 1); sm += __shfl_xor(sm, 2);
        const float mean = sm * (1.f / 128.f); float q = 0.f;
#pragma unroll
        for (int i = 0; i < 32; ++i) { v[i] -= mean; q += v[i] * v[i]; }
        q += __shfl_xor(q, 1); q += __shfl_xor(q, 2);
        const float rstd = 1.f / sqrtf(q * (1.f / 128.f) + LN_EPS);
        const float* gp = lng + 128 * g + 32 * seg; const float* bp = lnb + 128 * g + 32 * seg;
#pragma unroll
        for (int i = 0; i < 4; ++i) {
            const f32x4 g0 = *(const f32x4*)(gp + 8 * i), g1 = *(const f32x4*)(gp + 8 * i + 4), b0 = *(const f32x4*)(bp + 8 * i), b1 = *(const f32x4*)(bp + 8 * i + 4);
            u32x4 w;
            w.x = cvt_pk_bf16(v[8 * i + 0] * rstd * g0[0] + b0[0], v[8 * i + 1] * rstd * g0[1] + b0[1]);
            w.y = cvt_pk_bf16(v[8 * i + 2] * rstd * g0[2] + b0[2], v[8 * i + 3] * rstd * g0[3] + b0[3]);
            w.z = cvt_pk_bf16(v[8 * i + 4] * rstd * g1[0] + b1[0], v[8 * i + 5] * rstd * g1[1] + b1[1]);
            w.w = cvt_pk_bf16(v[8 * i + 6] * rstd * g1[2] + b1[2], v[8 * i + 7] * rstd * g1[3] + b1[3]);
            *(LAS u32x4*)(lds + s * VSTR + (32 * seg + 8 * i) * 2) = w;
        }
    }
    __syncthreads();
    const int t = 16 * wid + l15;
    f32x4 acc[8];
#pragma unroll
    for (int i = 0; i < 8; ++i) acc[i] = (f32x4){0.f, 0.f, 0.f, 0.f};
    const bf16_t* wp = TRIL + ((size_t)(g * 128 + t)) * 128 + 8 * quad;
    const unsigned voff = (8 * quad + (l15 >> 2)) * VSTR + (l15 & 3) * 8;
#pragma unroll
    for (int ks = 0; ks < 4; ++ks) {
        if (32 * ks <= 16 * wid + 15) {
            const bf16x8 wf = *(const bf16x8*)(wp + 32 * ks);
#pragma unroll
            for (int Td = 0; Td < 8; ++Td) {
                const s16x4 lo = att::vtr(lds + voff + (32 * ks) * VSTR + 32 * Td), hi = att::vtr(lds + voff + (32 * ks + 4) * VSTR + 32 * Td);
                const bf16x8 vf = (bf16x8){lo[0], lo[1], lo[2], lo[3], hi[0], hi[1], hi[2], hi[3]};
                acc[Td] = __builtin_amdgcn_mfma_f32_16x16x32_bf16(vf, wf, acc[Td], 0, 0, 0);
            }
        }
    }
    const float bt = bs[g * 128 + t];
    const bf16_t* up = Z + (row0 + t) * 1024 + 128 * g + 4 * quad;
    bf16_t* op = CAT + (row0 + t) * DM + 512 + 128 * g + 4 * quad;
#pragma unroll
    for (int Td = 0; Td < 8; ++Td) {
        const u32x2 uw = *(const u32x2*)(up + 16 * Td);
        u32x2 w; w.x = cvt_pk_bf16(bflo(uw.x) * (acc[Td][0] + bt), bfhi(uw.x) * (acc[Td][1] + bt)); w.y = cvt_pk_bf16(bflo(uw.y) * (acc[Td][2] + bt), bfhi(uw.y) * (acc[Td][3] + bt));
        *(u32x2*)(op + 16 * Td) = w;
    }
    __syncthreads();
}
}

#define RLX_AGENT __ATOMIC_RELAXED, __HIP_MEMORY_SCOPE_AGENT
#define XB_TMO      128
#define XB_XCNT(j)  (256  + 64 * (j))
#define XB_XSUB(j)  (1280 + 64 * (j))
#define XB_XGEN(j)  (2304 + 64 * (j))
#define XB_TOP      3328
#define XB_TOPGEN   3392
#define XCD_BAR_WORDS 3456
#define XB_SPIN_CAP (1u << 18)

__device__ __forceinline__ unsigned xb_ld(unsigned* p)              { return __hip_atomic_load(p, __ATOMIC_RELAXED, __HIP_MEMORY_SCOPE_AGENT); }
__device__ __forceinline__ unsigned xb_add(unsigned* p, unsigned v) { return __hip_atomic_fetch_add(p, v, __ATOMIC_RELAXED, __HIP_MEMORY_SCOPE_AGENT); }
__device__ __forceinline__ unsigned xb_xcc_id() { return (unsigned)__builtin_amdgcn_s_getreg((3 << 11) | 20) & 0xFu; }
#define XB_SPIN(cond, bar) do { unsigned _sp = 0; while (cond) { __builtin_amdgcn_s_sleep(1); \
    if ((++_sp & 255u) == 0u) { if (xb_ld(&(bar)[XB_TMO])) break; if (_sp > XB_SPIN_CAP) { atomicAdd(&(bar)[XB_TMO], 1u); break; } } } } while (0)

struct XcdBarrier {
    unsigned* bar; unsigned x;
    volatile LAS unsigned* st;
};

__device__ __forceinline__ XcdBarrier xcd_barrier_post(unsigned* bar, volatile LAS unsigned* st) {
    XcdBarrier b; b.bar = bar; b.x = xb_xcc_id(); b.st = st;
    if (threadIdx.x == 0) (void)xb_add(&bar[XB_XCNT(b.x)], 1u);
    return b;
}
__device__ __forceinline__ void xcd_barrier_complete(unsigned* bar, unsigned x, unsigned& nloc, unsigned& nx) {
    const unsigned G = gridDim.x * gridDim.y * gridDim.z;
    unsigned sum, cnt, mine, sp = 0u;
    for (;;) {
        sum = 0u; cnt = 0u; mine = 0u;
#pragma unroll
        for (unsigned j = 0; j < 16; ++j) { const unsigned c = xb_ld(&bar[XB_XCNT(j)]); sum += c; cnt += (c > 0u) ? 1u : 0u; mine = (j == x) ? c : mine; }
        if (sum == G) break;
        __builtin_amdgcn_s_sleep(1);
        if ((++sp & 255u) == 0u) { if (xb_ld(&bar[XB_TMO])) break; if (sp > XB_SPIN_CAP) { atomicAdd(&bar[XB_TMO], 1u); break; } }
    }
    nloc = mine > 0u ? mine : 1u; nx = cnt > 0u ? cnt : 1u;
}

__device__ __forceinline__ void xcd_barrier(const XcdBarrier& b) {
    asm volatile("s_waitcnt vmcnt(0)" ::: "memory");
    __syncthreads();
    if (threadIdx.x == 0) {
        unsigned* bar = b.bar;
        __builtin_amdgcn_s_waitcnt(0);
        unsigned nloc = b.st[0], nx = b.st[1];
        if (nloc == 0u) { xcd_barrier_complete(bar, b.x, nloc, nx); b.st[0] = nloc; b.st[1] = nx; }
        const unsigned old = xb_add(&bar[XB_XSUB(b.x)], 1u);
        const unsigned gen = old / nloc;
        if (old + 1u == (gen + 1u) * nloc) {
            __builtin_amdgcn_fence(__ATOMIC_RELEASE, "agent");
            asm volatile("s_waitcnt vmcnt(0)" ::: "memory");
            const unsigned og = xb_add(&bar[XB_TOP], 1u);
            const unsigned tg = og / nx;
            if (og + 1u == (tg + 1u) * nx) xb_add(&bar[XB_TOPGEN], 1u);
            else XB_SPIN(xb_ld(&bar[XB_TOPGEN]) == tg, bar);
            __builtin_amdgcn_fence(__ATOMIC_ACQUIRE, "agent");
            xb_add(&bar[XB_XGEN(b.x)], 1u);
            asm volatile("s_waitcnt vmcnt(0)" ::: "memory");
        } else {
            XB_SPIN(xb_ld(&bar[XB_XGEN(b.x)]) == gen, bar);
            __builtin_amdgcn_fence(__ATOMIC_ACQUIRE, "agent");
            asm volatile("s_waitcnt vmcnt(0)" ::: "memory");
        }
    }
    __syncthreads();
}

struct Args { const float* in[21]; float* out; unsigned char* ws; int ph_lo, ph_hi; };
enum { I_X = 0, I_WIN, I_LQ1, I_LK1, I_LQ2, I_LK2, I_SUBG, I_GLNG, I_GLNB, I_WSP, I_BSP, I_WOUT, I_LN1G, I_LN1B, I_WGATE, I_WUP, I_CONVW, I_CONVB, I_WDOWN, I_LN2G, I_LN2B };

__global__ void __launch_bounds__(512, 2) fwd(Args a) {
    extern __shared__ __attribute__((aligned(16))) unsigned char lds_raw[];
    LAS unsigned char* lds = (LAS unsigned char*)lds_raw;
    cg::grid_group grid = cg::this_grid();
    const int tid = threadIdx.x, lane = tid & 63, wave = __builtin_amdgcn_readfirstlane(tid >> 6);
    const int G = gridDim.x, bx = blockIdx.x;
    const int vcu = (G % 8 == 0) ? (bx % 8) * (G / 8) + bx / 8 : bx;
    unsigned char* ws = a.ws;
    bf16_t* WinT = (bf16_t*)(ws + WS_WIN); bf16_t* WoT = (bf16_t*)(ws + WS_WO); bf16_t* WguT = (bf16_t*)(ws + WS_WGU); bf16_t* WdT = (bf16_t*)(ws + WS_WD);
    float* ROPE = (float*)(ws + WS_ROPE); bf16_t* TRIL = (bf16_t*)(ws + WS_TRIL); bf16_t* X1B = (bf16_t*)(ws + WS_X1B);
    bf16_t* XB = (bf16_t*)(ws + WS_XB); bf16_t* QKV = (bf16_t*)(ws + WS_QKV); bf16_t* Zb = (bf16_t*)(ws + WS_Z); bf16_t* CAT = (bf16_t*)(ws + WS_CAT);
    bf16_t* Gb = (bf16_t*)(ws + WS_G); bf16_t* Ub = (bf16_t*)(ws + WS_U);
    const int lo = a.ph_lo, hi = a.ph_hi;
#define IN(k) (lo <= (k) && (k) < hi)
#define SEAM(k) do { if (IN(k) && IN((k) + 1)) { if ((k) == 0) { grid.sync(); bar = xcd_barrier_post(barw, MISC + 8); } else xcd_barrier(bar); } } while (0)
    unsigned* barw = (unsigned*)ws;
    volatile LAS unsigned* MISC = (volatile LAS unsigned*)(lds + 131072 + 320);
    if (tid < 32) MISC[tid] = 0u;
    __syncthreads();
    XcdBarrier bar; bar.bar = barw; bar.x = 0; bar.st = MISC + 8;

    if (IN(0)) {
        if (bx == 0) for (int i = tid; i < XCD_BAR_WORDS; i += 512) barw[i] = 0u;
        LAS float* scr = (LAS float*)(lds + wave * 16384);
        const int gw = vcu * 8 + wave, NGW = G * 8;
        constexpr int I_IN = (DM / 64) * (NIN / 32), I_O = (DM / 64) * (DM / 32), I_GU = (DM / 64) * (NGU / 32), I_D = (FF / 64) * (DM / 32);
        for (int it = gw; it < I_IN + I_O + I_GU + I_D; it += NGW) {
            int r = it;
            if (r < I_IN) { transpose_item<1>(a.in[I_WIN], nullptr, DM, NIN, NIN, WinT, scr, r, lane); continue; } r -= I_IN;
            if (r < I_O) { transpose_item<0>(a.in[I_WOUT], nullptr, DM, DM, DM, WoT, scr, r, lane); continue; } r -= I_O;
            if (r < I_GU) { transpose_item<2>(a.in[I_WGATE], a.in[I_WUP], DM, FF, NGU, WguT, scr, r, lane); continue; } r -= I_GU;
            transpose_item<0>(a.in[I_WDOWN], nullptr, FF, DM, DM, WdT, scr, r, lane);
        }
        const size_t gt = (size_t)bx * 512 + tid, NTH = (size_t)G * 512;
        for (size_t i = gt; i < (size_t)M * DM / 4; i += NTH) { const f32x4 v = ((const f32x4*)a.in[I_X])[i]; u32x2 w; w.x = cvt_pk_bf16(v.x, v.y); w.y = cvt_pk_bf16(v.z, v.w); ((u32x2*)XB)[i] = w; }
        for (size_t i = gt; i < (size_t)SEQ * 32; i += NTH) {
            const int pos = (int)(i >> 5), k = (int)(i & 31);
            const float inv = 1.0f / powf(10000.0f, (float)k * (1.0f / 32.0f));
            const float ang = (float)pos * inv;
            const double tw = 6.283185307179586476925; const double ad = (double)ang; const double n = __builtin_rint(ad * (1.0 / tw)); const float r = (float)(ad - n * tw);
            ROPE[pos * 64 + k] = cosf(r); ROPE[pos * 64 + 32 + k] = sinf(r);
        }
        for (size_t i = gt; i < (size_t)4 * 128 * 128; i += NTH) { const int s = (int)(i & 127), t = (int)((i >> 7) & 127); TRIL[i] = (bf16_t)f2bf(s <= t ? a.in[I_WSP][i] : 0.f); }
    }
    SEAM(0);
    if (IN(1)) {
        pg8::Gemm g{XB, WinT, M, NIN, DM}; pg8::StaticOrder S; S.init(M, NIN, G, bx);
        EpiIn E{QKV, Zb, ROPE};
        pg8::gemm_phase<EpiIn, pg8::StaticOrder, true, true>(lds, g, S, E);
    }
    SEAM(1);
    if (IN(2)) {
        float d1 = 0.f, d2 = 0.f;
        for (int i = 0; i < 64; ++i) { d1 += a.in[I_LQ1][i] * a.in[I_LK1][i]; d2 += a.in[I_LQ2][i] * a.in[I_LK2][i]; }
        const float lam = expf(d1) - expf(d2) + 0.2f;
        for (int sl = vcu; sl < 256; sl += G) {
            const int bh = sl >> 4, s = sl & 15;
            for (int i = 0; i < 4; ++i) { const int u = (i == 0) ? s : (i == 1) ? 31 - s : (i == 2) ? 32 + s : 63 - s; att::unit(lds, QKV, CAT, a.in[I_SUBG], lam, bh >> 2, bh & 3, u); }
        }
        for (int u = vcu; u < 1024; u += G) gm::unit(lds, Zb, CAT, TRIL, a.in[I_GLNG], a.in[I_GLNB], a.in[I_BSP], u >> 8, (u >> 2) & 63, u & 3);
    }
    SEAM(2);
    if (IN(3)) {
        pg8::Gemm g{CAT, WoT, M, DM, DM}; pg8::StaticOrder S; S.init(M, DM, G, bx);
        EpiRes E{a.in[I_X], a.out};
        pg8::gemm_phase<EpiRes, pg8::StaticOrder, true, true>(lds, g, S, E);
    }
    SEAM(3);
    if (IN(4)) { for (int m = vcu * 8 + wave; m < M; m += G * 8) ln_row(a.out + (size_t)m * DM, a.out + (size_t)m * DM, X1B + (size_t)m * DM, a.in[I_LN1G], a.in[I_LN1B], lane); }
    SEAM(4);
    if (IN(5)) {
        pg8::Gemm g{X1B, WguT, M, NGU, DM}; pg8::StaticOrder S; S.init(M, NGU, G, bx);
        EpiGU E{Gb, Ub};
        pg8::gemm_phase<EpiGU, pg8::StaticOrder, true, true>(lds, g, S, E);
    }
    SEAM(5);
    if (IN(6)) {
        const float* cw = a.in[I_CONVW]; const float* cb = a.in[I_CONVB];
        for (int task = bx * 512 + tid; task < (M / 32) * (FF / 8); task += G * 512) {
            const int cgp = task % (FF / 8), rr = task / (FF / 8), f0 = 8 * cgp, r0 = 32 * rr;
            float w0[8], w1[8], w2[8], bb[8], gm2[8], gm1[8];
#pragma unroll
            for (int i = 0; i < 8; ++i) { w0[i] = cw[f0 + i]; w1[i] = cw[FF + f0 + i]; w2[i] = cw[2 * FF + f0 + i]; bb[i] = cb[f0 + i]; }
            if ((r0 & (SEQ - 1)) != 0) {
                const u32x4 a2 = *(const u32x4*)(Gb + (size_t)(r0 - 2) * FF + f0), a1 = *(const u32x4*)(Gb + (size_t)(r0 - 1) * FF + f0);
                gm2[0] = bflo(a2.x); gm2[1] = bfhi(a2.x); gm2[2] = bflo(a2.y); gm2[3] = bfhi(a2.y); gm2[4] = bflo(a2.z); gm2[5] = bfhi(a2.z); gm2[6] = bflo(a2.w); gm2[7] = bfhi(a2.w);
                gm1[0] = bflo(a1.x); gm1[1] = bfhi(a1.x); gm1[2] = bflo(a1.y); gm1[3] = bfhi(a1.y); gm1[4] = bflo(a1.z); gm1[5] = bfhi(a1.z); gm1[6] = bflo(a1.w); gm1[7] = bfhi(a1.w);
            } else {
#pragma unroll
                for (int i = 0; i < 8; ++i) { gm2[i] = 0.f; gm1[i] = 0.f; }
            }
#pragma unroll 4
            for (int r = 0; r < 32; ++r) {
                const size_t off = (size_t)(r0 + r) * FF + f0;
                const u32x4 gw = *(const u32x4*)(Gb + off), uw = *(const u32x4*)(Ub + off);
                float gc[8], uu[8], o[8];
                gc[0] = bflo(gw.x); gc[1] = bfhi(gw.x); gc[2] = bflo(gw.y); gc[3] = bfhi(gw.y); gc[4] = bflo(gw.z); gc[5] = bfhi(gw.z); gc[6] = bflo(gw.w); gc[7] = bfhi(gw.w);
                uu[0] = bflo(uw.x); uu[1] = bfhi(uw.x); uu[2] = bflo(uw.y); uu[3] = bfhi(uw.y); uu[4] = bflo(uw.z); uu[5] = bfhi(uw.z); uu[6] = bflo(uw.w); uu[7] = bfhi(uw.w);
#pragma unroll
                for (int i = 0; i < 8; ++i) {
                    const float y = bb[i] + w0[i] * gm2[i] + w1[i] * gm1[i] + w2[i] * gc[i];
                    const float sg = __builtin_amdgcn_rcpf(1.0f + __builtin_amdgcn_exp2f(-1.4426950408889634f * y));
                    o[i] = y * sg * uu[i]; gm2[i] = gm1[i]; gm1[i] = gc[i];
                }
                u32x4 w; w.x = cvt_pk_bf16(o[0], o[1]); w.y = cvt_pk_bf16(o[2], o[3]); w.z = cvt_pk_bf16(o[4], o[5]); w.w = cvt_pk_bf16(o[6], o[7]);
                *(u32x4*)(Ub + off) = w;
            }
        }
    }
    SEAM(6);
    if (IN(7)) {
        pg8::Gemm g{Ub, WdT, M, DM, FF}; pg8::StaticOrder S; S.init(M, DM, G, bx);
        EpiRes E{a.out, a.out};
        pg8::gemm_phase<EpiRes, pg8::StaticOrder, true, true>(lds, g, S, E);
    }
    SEAM(7);
    if (IN(8)) { for (int m = vcu * 8 + wave; m < M; m += G * 8) ln_row(a.out + (size_t)m * DM, a.out + (size_t)m * DM, nullptr, a.in[I_LN2G], a.in[I_LN2B], lane); }
#undef IN
#undef SEAM
}

extern "C" void kernel_launch(void* const* d_in, const int* in_sizes, int n_in, void* d_out, int out_size, void* d_ws, size_t ws_size, hipStream_t stream) {
    static int grid = 0;
    if (grid == 0) {
        if (n_in != 21 || in_sizes[0] != M * DM || out_size != M * DM || ws_size < WS_END) { fprintf(stderr, "kernel_launch: unexpected shapes (n_in %d, in0 %d, out %d, ws %zu)\n", n_in, n_in > 0 ? in_sizes[0] : -1, out_size, ws_size); grid = -1; return; }
        int dev = 0, cus = 0, per_cu = 0;
        hipGetDevice(&dev); hipDeviceGetAttribute(&cus, hipDeviceAttributeMultiprocessorCount, dev);
        hipFuncSetAttribute((const void*)fwd, hipFuncAttributeMaxDynamicSharedMemorySize, LDS_BYTES);
        if (hipOccupancyMaxActiveBlocksPerMultiprocessor(&per_cu, (const void*)fwd, 512, LDS_BYTES) != hipSuccess || per_cu < 1) per_cu = 1;
        (void)hipGetLastError();
        grid = cus * per_cu;
        if (grid <= 0) grid = 256;
    }
    if (grid < 0) return;
    Args a{};
    for (int i = 0; i < 21; ++i) a.in[i] = (const float*)d_in[i];
    a.out = (float*)d_out; a.ws = (unsigned char*)d_ws;
#if MK_N_LAUNCHES == 1
    a.ph_lo = 0; a.ph_hi = NPHASE;
    void* args[] = {&a};
    hipError_t e = hipLaunchCooperativeKernel((const void*)fwd, dim3(grid), dim3(512), args, LDS_BYTES, stream);
    if (e != hipSuccess) fprintf(stderr, "cooperative launch failed: %s (grid %d)\n", hipGetErrorString(e), grid);
#else
    for (int p = 0; p < NPHASE; ++p) { a.ph_lo = p; a.ph_hi = p + 1; hipLaunchKernelGGL(fwd, dim3(grid), dim3(512), LDS_BYTES, stream, a); }
#endif
}
```
